# Optimizing an MI355X kernel written in HIP

```python
import math
import jax
import jax.numpy as jnp
from jax import lax
import numpy as np


D_MODEL = 1024
BATCH = 16
SEQ = 4096
DEPTH = 2

HEAD_DIM = 64
SB_HEADS = 6
RET_HEADS = 6
SB_WIDTH = SB_HEADS * HEAD_DIM
RET_WIDTH = RET_HEADS * HEAD_DIM
S5_WIDTH = D_MODEL - SB_WIDTH - RET_WIDTH
S5_GROUP_CH = 16
S5_GROUPS = S5_WIDTH // S5_GROUP_CH
S5_STATE = 64
D_MIX = SB_WIDTH + RET_WIDTH + S5_WIDTH
D_IN = 3 * SB_WIDTH + 4 * RET_WIDTH + S5_WIDTH
D_FF = ((8 * D_MODEL + 3 * 256 - 1) // (3 * 256)) * 256
CHUNK = 128
N_META = 16
PAD_FRONT = CHUNK - N_META
ROPE_BASE = 10000.0
RMS_EPS = 1e-6

kernel_name = "hymba_sb_retention_s5_hybrid"


def rmsnorm(x, g):
    x32 = x.astype(jnp.float32)
    y = x32 * lax.rsqrt(jnp.mean(x32 * x32, axis=-1, keepdims=True) + RMS_EPS)
    return y.astype(x.dtype) * g


def to_heads(t, n_heads):
    b, l, _ = t.shape
    return t.reshape(b, l, n_heads, HEAD_DIM).transpose(0, 2, 1, 3)


def from_heads(t):
    b, h, l, d = t.shape
    return t.transpose(0, 2, 1, 3).reshape(b, l, h * d)


def rotary(t, pos):
    half = HEAD_DIM // 2
    inv = ROPE_BASE ** (-jnp.arange(half, dtype=jnp.float32) / half)
    ang = pos[:, None] * inv[None, :]
    cos = jnp.cos(ang).astype(t.dtype)
    sin = jnp.sin(ang).astype(t.dtype)
    t1, t2 = t[..., :half], t[..., half:]
    return jnp.concatenate([t1 * cos - t2 * sin, t1 * sin + t2 * cos], axis=-1)


def stick_breaking(q, k, v):
    L = q.shape[2]
    scale = HEAD_DIM ** -0.5
    outs = []
    for blk in range(L // CHUNK):
        end = (blk + 1) * CHUNK
        qb = q[:, :, blk * CHUNK:end]
        kb = k[:, :, :end]
        vb = v[:, :, :end]
        z = jnp.einsum('bhqd,bhkd->bhqk', qb, kb).astype(jnp.float32) * scale
        t_idx = blk * CHUNK + jnp.arange(CHUNK)
        s_idx = jnp.arange(end)
        mask = (s_idx[None, :] < t_idx[:, None]) & (s_idx[None, :] >= PAD_FRONT)
        log1m = jnp.where(mask, jax.nn.log_sigmoid(-z), 0.0)
        between = lax.cumsum(log1m, axis=3, reverse=True) - log1m
        w = jnp.where(mask, jnp.exp(jax.nn.log_sigmoid(z) + between), 0.0)
        outs.append(jnp.einsum('bhqk,bhkd->bhqd', w.astype(vb.dtype), vb))
    return jnp.concatenate(outs, axis=2)


def retention(q, k, v, log_gamma):
    b, h, L, d = q.shape
    n = L // CHUNK
    k = k * (d ** -0.5)
    qc = q.reshape(b, h, n, CHUNK, d)
    kc = k.reshape(b, h, n, CHUNK, d)
    vc = v.reshape(b, h, n, CHUNK, d)
    i = jnp.arange(CHUNK, dtype=jnp.float32)
    diff = i[:, None] - i[None, :]
    decay_in = jnp.where(diff >= 0, jnp.exp(log_gamma[:, None, None] * jnp.maximum(diff, 0.0)), 0.0)
    scores = jnp.einsum('bhnid,bhnjd->bhnij', qc, kc) * decay_in[None, :, None]
    inner = jnp.einsum('bhnij,bhnje->bhnie', scores, vc.astype(jnp.float32))
    q_decay = jnp.exp(log_gamma[:, None] * (i + 1.0))
    k_decay = jnp.exp(log_gamma[:, None] * (CHUNK - 1.0 - i))
    chunk_decay = jnp.exp(log_gamma * CHUNK)
    xs = (jnp.moveaxis(qc.astype(jnp.float32) * q_decay[None, :, None, :, None], 2, 0),
          jnp.moveaxis(kc.astype(jnp.float32) * k_decay[None, :, None, :, None], 2, 0),
          jnp.moveaxis(vc.astype(jnp.float32), 2, 0))

    def step(state, inp):
        qn, kn, vn = inp
        cross = jnp.einsum('bhid,bhde->bhie', qn, state)
        state = state * chunk_decay[None, :, None, None] + jnp.einsum('bhjd,bhje->bhde', kn, vn)
        return state, cross

    s0 = jnp.zeros((b, h, d, d), jnp.float32)
    _, cross = lax.scan(step, s0, xs)
    o = inner + jnp.moveaxis(cross, 0, 2)
    return o.reshape(b, h, L, d)


def _complex_affine_combine(e1, e2):
    a1r, a1i, b1r, b1i = e1
    a2r, a2i, b2r, b2i = e2
    return (a2r * a1r - a2i * a1i,
            a2r * a1i + a2i * a1r,
            a2r * b1r - a2i * b1i + b2r,
            a2r * b1i + a2i * b1r + b2i)


def s5_mixer(u, lam_re, lam_im, log_dt, b_re, b_im, c_re, c_im, d_skip, w_glu):
    bsz, L, _ = u.shape
    f32 = jnp.float32
    u32 = u.astype(f32)
    ug = jnp.transpose(u32.reshape(bsz, L, S5_GROUPS, S5_GROUP_CH), (1, 0, 2, 3))
    lr = lam_re.astype(f32)
    li = lam_im.astype(f32)
    dt = jnp.exp(log_dt.astype(f32))[:, None]
    mag = jnp.exp(lr * dt)
    ar = mag * jnp.cos(li * dt)
    ai = mag * jnp.sin(li * dt)
    den = lr * lr + li * li
    fr = ((ar - 1.0) * lr + ai * li) / den
    fi = (ai * lr - (ar - 1.0) * li) / den
    br = b_re.astype(f32)
    bi = b_im.astype(f32)
    bbr = fr[..., None] * br - fi[..., None] * bi
    bbi = fr[..., None] * bi + fi[..., None] * br
    bu_r = jnp.einsum('lbgc,gpc->lbgp', ug, bbr)
    bu_i = jnp.einsum('lbgc,gpc->lbgp', ug, bbi)
    a_r = jnp.broadcast_to(ar[None, None], (L, 1, S5_GROUPS, S5_STATE))
    a_i = jnp.broadcast_to(ai[None, None], (L, 1, S5_GROUPS, S5_STATE))
    _, _, xr, xi = lax.associative_scan(_complex_affine_combine, (a_r, a_i, bu_r, bu_i), axis=0)
    y = (jnp.einsum('lbgp,gcp->lbgc', xr, c_re.astype(f32))
         - jnp.einsum('lbgp,gcp->lbgc', xi, c_im.astype(f32)))
    y = jnp.transpose(y, (1, 0, 2, 3)).reshape(bsz, L, S5_WIDTH) + d_skip.astype(f32) * u32
    y = jax.nn.gelu(y)
    return (y * jax.nn.sigmoid(y @ w_glu.astype(f32))).astype(u.dtype)


def setup_inputs(seed: int = 0) -> dict:
    key = jax.random.key(seed)
    ks = jax.random.split(key, 24)
    f32 = jnp.float32

    def nrm(k, shape, scale):
        return scale * jax.random.normal(k, shape, f32)

    return {
        'x': nrm(ks[0], (BATCH, SEQ, D_MODEL), 1.0),
        'meta_tokens': nrm(ks[1], (N_META, D_MODEL), 1.0),
        'norm1_g': 1.0 + nrm(ks[2], (DEPTH, D_MODEL), 0.02),
        'w_in': nrm(ks[3], (DEPTH, D_MODEL, D_IN), D_MODEL ** -0.5),
        'sb_q_g': 1.0 + nrm(ks[4], (DEPTH, HEAD_DIM), 0.02),
        'sb_k_g': 1.0 + nrm(ks[5], (DEPTH, HEAD_DIM), 0.02),
        'ret_q_g': 1.0 + nrm(ks[6], (DEPTH, HEAD_DIM), 0.02),
        'ret_k_g': 1.0 + nrm(ks[7], (DEPTH, HEAD_DIM), 0.02),
        'ret_out_g': 1.0 + nrm(ks[8], (DEPTH, RET_WIDTH), 0.02),
        's5_lam_re': -0.5 + nrm(ks[9], (DEPTH, S5_GROUPS, S5_STATE), 0.01),
        's5_lam_im': math.pi * jnp.arange(S5_STATE, dtype=f32) + nrm(ks[10], (DEPTH, S5_GROUPS, S5_STATE), 0.01),
        's5_log_dt': jax.random.uniform(ks[11], (DEPTH, S5_GROUPS), f32, math.log(1e-3), math.log(1e-1)),
        's5_b_re': nrm(ks[12], (DEPTH, S5_GROUPS, S5_STATE, S5_GROUP_CH), (2 * S5_GROUP_CH) ** -0.5),
        's5_b_im': nrm(ks[13], (DEPTH, S5_GROUPS, S5_STATE, S5_GROUP_CH), (2 * S5_GROUP_CH) ** -0.5),
        's5_c_re': nrm(ks[14], (DEPTH, S5_GROUPS, S5_GROUP_CH, S5_STATE), (2 * S5_STATE) ** -0.5),
        's5_c_im': nrm(ks[15], (DEPTH, S5_GROUPS, S5_GROUP_CH, S5_STATE), (2 * S5_STATE) ** -0.5),
        's5_d': nrm(ks[16], (DEPTH, S5_WIDTH), 1.0),
        's5_w_glu': nrm(ks[17], (DEPTH, S5_WIDTH, S5_WIDTH), S5_WIDTH ** -0.5),
        'w_out': nrm(ks[18], (DEPTH, D_MIX, D_MODEL), D_MIX ** -0.5),
        'norm2_g': 1.0 + nrm(ks[19], (DEPTH, D_MODEL), 0.02),
        'w_gate': nrm(ks[20], (DEPTH, D_MODEL, D_FF), D_MODEL ** -0.5),
        'w_up': nrm(ks[21], (DEPTH, D_MODEL, D_FF), D_MODEL ** -0.5),
        'w_down': nrm(ks[22], (DEPTH, D_FF, D_MODEL), D_FF ** -0.5),
    }


def reference(x, meta_tokens, norm1_g, w_in, sb_q_g, sb_k_g, ret_q_g, ret_k_g, ret_out_g,
              s5_lam_re, s5_lam_im, s5_log_dt, s5_b_re, s5_b_im, s5_c_re, s5_c_im, s5_d, s5_w_glu,
              w_out, norm2_g, w_gate, w_up, w_down):
    bsz = x.shape[0]
    L = PAD_FRONT + N_META + x.shape[1]
    pad = jnp.zeros((bsz, PAD_FRONT, D_MODEL), x.dtype)
    meta = jnp.broadcast_to(meta_tokens[None].astype(x.dtype), (bsz, N_META, D_MODEL))
    h = jnp.concatenate([pad, meta, x], axis=1)
    idx = jnp.arange(L)
    valid = (idx >= PAD_FRONT).astype(x.dtype)[None, :, None]
    pos = (idx - PAD_FRONT).astype(jnp.float32)
    log_gamma = jnp.log1p(-jnp.exp2(-5.0 - jnp.arange(RET_HEADS, dtype=jnp.float32)))
    splits = [SB_WIDTH, 2 * SB_WIDTH, 3 * SB_WIDTH,
              3 * SB_WIDTH + RET_WIDTH, 3 * SB_WIDTH + 2 * RET_WIDTH,
              3 * SB_WIDTH + 3 * RET_WIDTH, 3 * SB_WIDTH + 4 * RET_WIDTH]
    for l in range(DEPTH):
        hn = rmsnorm(h, norm1_g[l])
        proj = hn @ w_in[l]
        sq, sk, sv, rq, rk, rv, rg, u = jnp.split(proj, splits, axis=-1)
        q = rmsnorm(to_heads(sq, SB_HEADS), sb_q_g[l])
        k = rmsnorm(to_heads(sk, SB_HEADS), sb_k_g[l])
        sb_o = from_heads(stick_breaking(q, k, to_heads(sv, SB_HEADS)))
        q = rotary(rmsnorm(to_heads(rq, RET_HEADS), ret_q_g[l]), pos)
        k = rotary(rmsnorm(to_heads(rk, RET_HEADS), ret_k_g[l]), pos)
        ro = retention(q, k, to_heads(rv, RET_HEADS), log_gamma).transpose(0, 2, 1, 3)
        ro = rmsnorm(ro, ret_out_g[l].reshape(RET_HEADS, HEAD_DIM)).reshape(bsz, L, RET_WIDTH)
        ro = ro * jax.nn.silu(rg)
        so = s5_mixer(u, s5_lam_re[l], s5_lam_im[l], s5_log_dt[l], s5_b_re[l], s5_b_im[l],
                      s5_c_re[l], s5_c_im[l], s5_d[l], s5_w_glu[l])
        mix = jnp.concatenate([sb_o.astype(h.dtype), ro.astype(h.dtype), so.astype(h.dtype)], axis=-1)
        h = h + (mix @ w_out[l]).astype(h.dtype)
        hn = rmsnorm(h, norm2_g[l])
        h = h + ((jax.nn.silu(hn @ w_gate[l]) * (hn @ w_up[l])) @ w_down[l]).astype(h.dtype)
        h = h * valid
    return h[:, PAD_FRONT + N_META:]
```

```cpp
#include <hip/hip_runtime.h>
#include <hip/hip_cooperative_groups.h>
#include <cstdio>
namespace cg = cooperative_groups;

namespace pg8 {
#define PG8_LAS __attribute__((address_space(3)))
typedef unsigned short bf16_t;
typedef short bf16x8 __attribute__((ext_vector_type(8)));
typedef float f32x4 __attribute__((ext_vector_type(4)));
typedef unsigned u32x4 __attribute__((ext_vector_type(4)));
__device__ __forceinline__ int tid_fresh() { int t = threadIdx.x; asm volatile("" : "+v"(t)); return t; }
__device__ __forceinline__ int sgpr_fresh(int v) { asm volatile("" : "+s"(v)); return v; }
constexpr int BM = 256, BK = 64, HALF = 128, HTB = HALF * BK * 2  , STAGE_BYTES = 8 * HTB, NXCD = 8, WGM = 8;

__host__ __device__ __forceinline__ int lds_byte(int r, int c) { const int st = (r >> 4) * 2 + (c >> 5), rr = r & 15, cc = c & 31, ob = rr * 64 + cc * 2; return st * 1024 + (ob ^ (((ob >> 9) & 1) << 5)); }
__host__ __device__ __forceinline__ void stage_rc(int b, int& R, int& C) { const int st = b / 1024, sb = b % 1024, swz = sb ^ (((sb >> 9) & 1) << 5); R = (st >> 1) * 16 + swz / 64; C = (st & 1) * 32 + (swz % 64) / 2; }
__host__ __device__ __forceinline__ int perm32(int rho) { const int n = rho >> 4, i = rho & 15; return 8 * (i >> 2) + 4 * n + (i & 3); }

struct Unit { int pm, pn; };
struct Gemm { const bf16_t* A; const bf16_t* Bt; int M, N, K; };

struct StaticOrder {
    int nM, nN, nwg, G, c;
    __host__ __device__ void init(int M, int N, int G_, int c_) { nM = M / BM; nN = N / BM; nwg = nM * nN; G = G_; c = c_; }
    __host__ __device__ bool next(int i, Unit& u) const {
        const long L = (long)i * G + c; if (L >= nwg) return false;
        int wgid = (int)L; { const int q = nwg / NXCD, r = nwg % NXCD, xcd = wgid % NXCD, off = wgid / NXCD; wgid = (xcd < r ? xcd * (q + 1) : r * (q + 1) + (xcd - r) * q) + off; }
        const int nig = WGM * nN, gid = wgid / nig, fm = gid * WGM, gsz = (nM - fm) < WGM ? (nM - fm) : WGM;
        u.pm = fm + ((wgid % nig) % gsz); u.pn = (wgid % nig) / gsz; return true;
    }
    __device__ __forceinline__ void a_ready(const Unit&) const {}
    __device__ __forceinline__ void done(const Unit&) const {}
};
__device__ __forceinline__ unsigned cvt_pk_bf16(float lo, float hi) { unsigned r; asm volatile("v_cvt_pk_bf16_f32 %0, %1, %2" : "=v"(r) : "v"(lo), "v"(hi)); return r; }

template <class Epi, class Sched, bool STAMP = false>
__device__ __forceinline__ void gemm_phase(PG8_LAS unsigned char* lds, const Gemm g, const Sched& S, const Epi& E, unsigned long long* stamps) {
    const int tid = tid_fresh(), wid = __builtin_amdgcn_readfirstlane(tid >> 6), lane = tid & 63, wr = wid >> 2, wc = wid & 3, fr = lane & 15, fq = lane >> 4;
    const int K = g.K, nt = K / BK;
    int ts_lo = 0, ts_hi = 0, nts = 0; const unsigned long long rt_entry = STAMP ? (unsigned long long)wall_clock64() : 0ull;
#define PG8_STAMP() do { if (STAMP && wid == 0 && nts < 64) { const unsigned long long _c = (unsigned long long)clock64(); \
        ts_lo = (lane == nts) ? (int)(unsigned)_c : ts_lo; ts_hi = (lane == nts) ? (int)(unsigned)(_c >> 32) : ts_hi; ++nts; } } while (0)
    PG8_STAMP();
    unsigned voffA[2], voffB[2];
#pragma unroll
    for (int i = 0; i < 2; ++i) { int R, C; stage_rc(tid * 16 + i * 8192, R, C); const int Rb = Epi::PERM ? ((R & ~31) + perm32(R & 31)) : R;
        voffA[i] = (unsigned)(R * K + C) * 2u; voffB[i] = (unsigned)(Rb * K + C) * 2u; }
    const size_t kstep = (size_t)(BK * 2);
    const size_t hstep = (size_t)HALF * K * 2;
    const size_t tstep = 2 * hstep;
    const unsigned ldsw = (unsigned)wid * 1024u;
    const int aoff = lds_byte(wr * 64 + fr, fq * 8), boff = lds_byte(wc * 32 + fr, fq * 8);
#define PG8_SA(b, h) (((b) * 2 + (h)) * HTB)
#define PG8_SB(b, h) ((4 + (b) * 2 + (h)) * HTB)
#define PG8_STAGE(bufoff, gbase, voff) do { _Pragma("unroll") for (int _i = 0; _i < 2; ++_i) \
        __builtin_amdgcn_global_load_lds((const unsigned*)((const char*)(gbase) + (voff)[_i]), (PG8_LAS unsigned*)(lds + (bufoff) + ldsw + _i * 8192), 16, 0, 0); } while (0)
#define PG8_LDA(dst, b, h) do { _Pragma("unroll") for (int m = 0; m < 4; ++m) _Pragma("unroll") for (int k = 0; k < 2; ++k) dst[m][k] = *(const PG8_LAS bf16x8*)(lds + PG8_SA(b, h) + aoff + m * 2048 + k * 1024); } while (0)
#define PG8_LDB(dst, b, h) do { _Pragma("unroll") for (int n = 0; n < 2; ++n) _Pragma("unroll") for (int k = 0; k < 2; ++k) dst[n][k] = *(const PG8_LAS bf16x8*)(lds + PG8_SB(b, h) + boff + n * 2048 + k * 1024); } while (0)
#define PG8_MMA(ai, bj, At, Bt) do { __builtin_amdgcn_s_setprio(1); _Pragma("unroll") for (int m = 0; m < 4; ++m) _Pragma("unroll") for (int n = 0; n < 2; ++n) _Pragma("unroll") for (int k = 0; k < 2; ++k) \
        acc[ai][bj][m][n] = __builtin_amdgcn_mfma_f32_16x16x32_bf16(Bt[n][k], At[m][k], acc[ai][bj][m][n], 0, 0, 0); __builtin_amdgcn_s_setprio(0); } while (0)
#define PG8_WAIT_V(n) asm volatile("s_waitcnt vmcnt(" #n ")" ::: "memory")
#define PG8_WAIT_L(n) asm volatile("s_waitcnt lgkmcnt(" #n ")" ::: "memory")
#define PG8_BAR __builtin_amdgcn_s_barrier()
#define PG8_SCHED __builtin_amdgcn_sched_barrier(0)
    Unit cur, nxt; int ui = 0;
    if (!S.next(0, cur)) return;
    f32x4 acc[2][2][4][2];
#pragma unroll
    for (int a = 0; a < 2; ++a)
#pragma unroll
        for (int b = 0; b < 2; ++b)
#pragma unroll
            for (int m = 0; m < 4; ++m)
#pragma unroll
                for (int n = 0; n < 2; ++n) acc[a][b][m][n] = (f32x4){0.f, 0.f, 0.f, 0.f};
    bf16x8 At[4][2], B0[2][2], B1[2][2];
    const char* cA = (const char*)g.A + (size_t)cur.pm * tstep; const char* cB = (const char*)g.Bt + (size_t)cur.pn * tstep;
    S.a_ready(cur);
    PG8_STAGE(PG8_SB(0, 0), cB, voffB); PG8_STAGE(PG8_SA(0, 0), cA, voffA); PG8_STAGE(PG8_SB(0, 1), cB + hstep, voffB); PG8_STAGE(PG8_SA(0, 1), cA + hstep, voffA);
    if (wr == 1) PG8_BAR;
    PG8_WAIT_V(4); PG8_BAR;
    PG8_STAGE(PG8_SB(1, 0), cB + kstep, voffB); PG8_STAGE(PG8_SA(1, 0), cA + kstep, voffA); PG8_STAGE(PG8_SB(1, 1), cB + hstep + kstep, voffB);
    PG8_WAIT_V(6); PG8_BAR;
    PG8_STAMP();
    for (;;) {
        const bool has_next = S.next(ui + 1, nxt);
        const char* nA = has_next ? (const char*)g.A + (size_t)nxt.pm * tstep : cA; const char* nB = has_next ? (const char*)g.Bt + (size_t)nxt.pn * tstep : cB;
#pragma unroll 1
        for (int t = 0; t < nt; t += 2) {
            const bool last = (t == nt - 2);
            const char* a1 = cA + (size_t)(t + 1) * kstep;
            const char* a2 = last ? nA : cA + (size_t)(t + 2) * kstep; const char* b2 = last ? nB : cB + (size_t)(t + 2) * kstep;
            const char* a3 = a2 + kstep; const char* b3 = b2 + kstep;
            if (last && has_next) S.a_ready(nxt);
            PG8_LDB(B0, 0, 0); PG8_SCHED; PG8_LDA(At, 0, 0); PG8_STAGE(PG8_SA(1, 1), a1 + hstep, voffA);
            PG8_WAIT_L(8); PG8_BAR; PG8_WAIT_L(0); PG8_MMA(0, 0, At, B0); PG8_BAR; PG8_SCHED;
            PG8_LDB(B1, 0, 1); PG8_STAGE(PG8_SB(0, 0), b2, voffB);
            PG8_BAR; PG8_WAIT_L(0); PG8_MMA(0, 1, At, B1); PG8_BAR;
            PG8_LDA(At, 0, 1); PG8_STAGE(PG8_SA(0, 0), a2, voffA);
            PG8_BAR; PG8_WAIT_L(0); PG8_MMA(1, 0, At, B0); PG8_BAR; PG8_SCHED;
            PG8_STAGE(PG8_SB(0, 1), b2 + hstep, voffB);
            PG8_WAIT_V(6); PG8_BAR; PG8_MMA(1, 1, At, B1); PG8_BAR;
            PG8_LDB(B0, 1, 0); PG8_SCHED; PG8_LDA(At, 1, 0); PG8_STAGE(PG8_SA(0, 1), a2 + hstep, voffA);
            PG8_WAIT_L(8); PG8_BAR; PG8_WAIT_L(0); PG8_MMA(0, 0, At, B0); PG8_BAR; PG8_SCHED;
            PG8_LDB(B1, 1, 1); PG8_STAGE(PG8_SB(1, 0), b3, voffB);
            PG8_BAR; PG8_WAIT_L(0); PG8_MMA(0, 1, At, B1); PG8_BAR;
            PG8_LDA(At, 1, 1); PG8_STAGE(PG8_SA(1, 0), a3, voffA);
            PG8_BAR; PG8_WAIT_L(0); PG8_MMA(1, 0, At, B0); PG8_BAR; PG8_SCHED;
            PG8_STAGE(PG8_SB(1, 1), b3 + hstep, voffB);
            PG8_WAIT_V(6); PG8_BAR; PG8_MMA(1, 1, At, B1); PG8_BAR;
        }
        PG8_STAMP();
        if constexpr (!Epi::AFTER_DRAIN) { E(acc, cur, wr, wc, fr, fq); S.done(cur); }
        PG8_STAMP();
        if (!has_next) break;
#pragma unroll
        for (int a = 0; a < 2; ++a)
#pragma unroll
            for (int b = 0; b < 2; ++b)
#pragma unroll
                for (int m = 0; m < 4; ++m)
#pragma unroll
                    for (int n = 0; n < 2; ++n) acc[a][b][m][n] = (f32x4){0.f, 0.f, 0.f, 0.f};
        cur = nxt; cA = nA; cB = nB; ++ui;
    }
    PG8_WAIT_V(0);
    if (wr == 0) PG8_BAR;
    PG8_BAR;
    if constexpr (Epi::AFTER_DRAIN) { E.fused(acc, cur, wr, wc, fr, fq, lds, wid, lane); S.done(cur); }
    PG8_STAMP();
    if (STAMP && wid == 0) { stamps[lane] = lane < nts ? (((unsigned long long)(unsigned)ts_hi << 32) | (unsigned)ts_lo) : 0ull;
        if (lane == 62) stamps[62] = rt_entry; if (lane == 63) stamps[63] = (unsigned long long)wall_clock64(); }
#undef PG8_STAMP
#undef PG8_SA
#undef PG8_SB
#undef PG8_STAGE
#undef PG8_LDA
#undef PG8_LDB
#undef PG8_MMA
#undef PG8_WAIT_V
#undef PG8_WAIT_L
#undef PG8_BAR
#undef PG8_SCHED
}
}
using namespace pg8;
typedef short bf16x4 __attribute__((ext_vector_type(4)));
typedef float f32x16 __attribute__((ext_vector_type(16)));
typedef unsigned u32x2 __attribute__((ext_vector_type(2)));

constexpr int DM = 1024, NBATCH = 16, SEQ = 4096, LP = 4224, MROWS = NBATCH * LP, DINP = 3072, DFF = 2816;
constexpr int NCH32 = LP / 32;
constexpr int S5ROWS = 2304;
constexpr float RMS_EPS = 1e-6f, LOG2E = 1.4426950408889634f;

constexpr size_t SZ_HB = (size_t)MROWS * 1024 * 2;
constexpr size_t OFF_HB = 0;
constexpr size_t OFF_URE = OFF_HB, OFF_YBUF = OFF_HB;
constexpr size_t SZ_URE = (size_t)16 * S5ROWS * 512 * 2;
constexpr size_t OFF_YLOC = OFF_URE + SZ_URE;
constexpr size_t OFF_XEND = OFF_YLOC + SZ_URE;
constexpr size_t SZ_XEND = (size_t)16 * S5ROWS * 128 * 4;
constexpr size_t OFF_XST = OFF_XEND + SZ_XEND;
constexpr size_t SZ_XST = (size_t)16 * S5ROWS * 256 * 2;
static_assert(OFF_XST + SZ_XST <= SZ_HB, "s5 temporaries must fit in the hb region");
constexpr size_t OFF_PROJ = OFF_HB + SZ_HB;
constexpr size_t SZ_PROJ = (size_t)MROWS * DINP * 2;
constexpr size_t OFF_ACT = OFF_PROJ;
constexpr size_t SZ_T = (size_t)MROWS * 384 * 2;
constexpr size_t OFF_VST = OFF_PROJ + SZ_PROJ, OFF_VRT = OFF_VST + SZ_T, OFF_KRT = OFF_VRT + SZ_T;
constexpr size_t OFF_MIX = OFF_KRT + SZ_T;
constexpr size_t OFF_W = OFF_MIX + SZ_HB;
constexpr size_t WL_IN = 0, WL_OUT = (size_t)DINP * 1024 * 2, WL_GU = WL_OUT + (size_t)1024 * 1024 * 2, WL_DN = WL_GU + (size_t)5632 * 1024 * 2,
                 WL_GLU = WL_DN + (size_t)1024 * DFF * 2, SZ_WL = WL_GLU + (size_t)256 * 256 * 2;
constexpr size_t OFF_S5M = OFF_W + 2 * SZ_WL;
constexpr size_t S5M_BT1 = 0, S5M_E = (size_t)16 * 768 * 512 * 2, SZ_S5M = S5M_E + (size_t)16 * 512 * 256 * 2;
constexpr size_t OFF_SSQ = OFF_S5M + 2 * SZ_S5M;
constexpr size_t OFF_HMETA = OFF_SSQ + (size_t)MROWS * 16 * 4;
constexpr size_t OFF_ROT = OFF_HMETA + (size_t)NBATCH * 128 * 1024 * 4;
constexpr size_t OFF_S5P = OFF_ROT + (size_t)LP * 32 * 2 * 4;
constexpr size_t S5P_BB = 0, S5P_PW = (size_t)16 * 64 * 16 * 2 * 4, SZ_S5P = S5P_PW + (size_t)16 * 64 * 33 * 2 * 4;
constexpr size_t OFF_CTR = OFF_S5P + 2 * SZ_S5P;
constexpr size_t WS_NEED = OFF_CTR + 256;
static_assert(WS_NEED < (size_t)1000 * 1024 * 1024, "workspace too large");

struct Params {
    const float *x, *meta, *norm1_g, *w_in, *sb_q_g, *sb_k_g, *ret_q_g, *ret_k_g, *ret_out_g, *lam_re, *lam_im, *log_dt, *b_re, *b_im, *c_re, *c_im, *s5_d, *w_glu,
        *w_out, *norm2_g, *w_gate, *w_up, *w_down;
    float* out;
    unsigned char* ws;
};

__device__ __forceinline__ float bf2f(bf16_t v) { return __uint_as_float(((unsigned)v) << 16); }
__device__ __forceinline__ bf16_t f2bf(float f) { unsigned u = __float_as_uint(f); u += 0x7FFFu + ((u >> 16) & 1u); return (bf16_t)(u >> 16); }
__device__ __forceinline__ float lo_bf(unsigned w) { return __uint_as_float(w << 16); }
__device__ __forceinline__ float hi_bf(unsigned w) { return __uint_as_float(w & 0xffff0000u); }
__device__ __forceinline__ u32x4 pack8(const float* f) { u32x4 w; w.x = cvt_pk_bf16(f[0], f[1]); w.y = cvt_pk_bf16(f[2], f[3]); w.z = cvt_pk_bf16(f[4], f[5]); w.w = cvt_pk_bf16(f[6], f[7]); return w; }
__device__ __forceinline__ void unpack8(u32x4 w, float* f) { f[0] = lo_bf(w.x); f[1] = hi_bf(w.x); f[2] = lo_bf(w.y); f[3] = hi_bf(w.y); f[4] = lo_bf(w.z); f[5] = hi_bf(w.z); f[6] = lo_bf(w.w); f[7] = hi_bf(w.w); }
__device__ __forceinline__ float log_gamma_h(int h) { const float x = __builtin_amdgcn_exp2f(-5.0f - (float)h); return -x * (1.0f + x * (0.5f + x * (0.33333334f + x * (0.25f + x * 0.2f)))); }
__device__ __forceinline__ float sigmoidf_(float v) { return 1.0f / (1.0f + __expf(-v)); }
__device__ __forceinline__ float gelu_tanh(float y) { const float t = 1.5957691216057308f * (y + 0.044715f * y * y * y); return y / (1.0f + __expf(-t)); }
#define MFMA32(a, b, c) __builtin_amdgcn_mfma_f32_32x32x16_bf16((a), (b), (c), 0, 0, 0)

struct BatchedOrder {
    int nPm, nPn, nwg, G, c;
    __device__ void init(int nG, int nPm_, int nPn_, int G_, int c_) { nPm = nPm_; nPn = nPn_; nwg = nG * nPm_ * nPn_; G = G_; c = c_; }
    __device__ bool next(int i, Unit& u) const {
        const long L = (long)i * G + c; if (L >= nwg) return false;
        const int per = nPm * nPn, g = (int)L / per, rem = (int)L % per; u.pm = g * nPm + rem / nPn; u.pn = g * nPn + rem % nPn; return true;
    }
    __device__ __forceinline__ void a_ready(const Unit&) const {}
    __device__ __forceinline__ void done(const Unit&) const {}
};

__device__ __forceinline__ float row_rs(const float* ssq, int row) {
    const f32x4* sp = (const f32x4*)(ssq + (size_t)row * 16); const f32x4 s = sp[0] + sp[1] + sp[2] + sp[3];
    return rsqrtf((s.x + s.y + s.z + s.w) * (1.0f / 1024.0f) + RMS_EPS);
}

struct EpiProj {
    static constexpr bool PERM = true, AFTER_DRAIN = false;
    bf16_t* O; const float* ssq;
    __device__ __forceinline__ void operator()(const f32x4 (&acc)[2][2][4][2], const Unit& u, int wr, int wc, int fr, int fq) const {
        const int row0 = u.pm * BM + wr * 64 + fr, col0 = u.pn * BM + wc * 32 + 8 * fq;
#pragma unroll
        for (int ai = 0; ai < 2; ++ai)
#pragma unroll
            for (int m = 0; m < 4; ++m) { const int row = row0 + ai * HALF + m * 16; const float rs = row_rs(ssq, row); bf16_t* rowp = O + (size_t)row * DINP + col0;
#pragma unroll
                for (int bj = 0; bj < 2; ++bj) { const f32x4 v0 = acc[ai][bj][m][0] * rs, v1 = acc[ai][bj][m][1] * rs;
                    u32x4 w; w.x = cvt_pk_bf16(v0[0], v0[1]); w.y = cvt_pk_bf16(v0[2], v0[3]); w.z = cvt_pk_bf16(v1[0], v1[1]); w.w = cvt_pk_bf16(v1[2], v1[3]);
                    *(u32x4*)(rowp + bj * HALF) = w; } }
    }
};

struct EpiAct {
    static constexpr bool PERM = true, AFTER_DRAIN = false;
    bf16_t* O; const float* ssq;
    __device__ __forceinline__ void operator()(const f32x4 (&acc)[2][2][4][2], const Unit& u, int wr, int wc, int fr, int fq) const {
        const int row0 = u.pm * BM + wr * 64 + fr, col0 = u.pn * HALF + wc * 32 + 8 * fq;
#pragma unroll
        for (int ai = 0; ai < 2; ++ai)
#pragma unroll
            for (int m = 0; m < 4; ++m) { const int row = row0 + ai * HALF + m * 16; const float rs = row_rs(ssq, row); float o[8];
#pragma unroll
                for (int n = 0; n < 2; ++n)
#pragma unroll
                    for (int j = 0; j < 4; ++j) { const float g = acc[ai][0][m][n][j] * rs, up = acc[ai][1][m][n][j] * rs; o[n * 4 + j] = g * sigmoidf_(g) * up; }
                *(u32x4*)(O + (size_t)row * DFF + col0) = pack8(o); __builtin_amdgcn_sched_barrier(0); }
    }
};

struct EpiRes {
    static constexpr bool PERM = true, AFTER_DRAIN = false;
    const float* src_main; const float* src_meta; float* dst_main; float* dst_meta; bf16_t* hb; float* ssq; int last;
    __device__ __forceinline__ void operator()(const f32x4 (&acc)[2][2][4][2], const Unit& u, int wr, int wc, int fr, int fq) const {
        const int row0 = u.pm * BM + wr * 64 + fr, col0 = u.pn * BM + wc * 32 + 8 * fq;
#pragma unroll
        for (int ai = 0; ai < 2; ++ai)
#pragma unroll
            for (int m = 0; m < 4; ++m) { const int row = row0 + ai * HALF + m * 16; const int b = row / LP, i = row - b * LP;
                const bool ism = i < 128; const size_t off = ism ? (size_t)(b * 128 + i) * 1024 : ((size_t)b * SEQ + (i - 128)) * 1024;
                const float* s = (ism ? src_meta : src_main) + off + col0; float* d = (ism ? dst_meta : dst_main) + off + col0;
                const float valid = i >= 112 ? 1.0f : 0.0f; float part = 0.f;
#pragma unroll
                for (int bj = 0; bj < 2; ++bj) {
                    const f32x4 h0 = *(const f32x4*)(s + bj * HALF), h1 = *(const f32x4*)(s + bj * HALF + 4);
                    const f32x4 v0 = (h0 + acc[ai][bj][m][0]) * valid, v1 = (h1 + acc[ai][bj][m][1]) * valid;
                    *(f32x4*)(d + bj * HALF) = v0; *(f32x4*)(d + bj * HALF + 4) = v1;
                    if (!last) { u32x4 w; w.x = cvt_pk_bf16(v0[0], v0[1]); w.y = cvt_pk_bf16(v0[2], v0[3]); w.z = cvt_pk_bf16(v1[0], v1[1]); w.w = cvt_pk_bf16(v1[2], v1[3]);
                        *(u32x4*)(hb + (size_t)row * 1024 + col0 + bj * HALF) = w;
                        part += v0[0] * v0[0] + v0[1] * v0[1] + v0[2] * v0[2] + v0[3] * v0[3] + v1[0] * v1[0] + v1[1] * v1[1] + v1[2] * v1[2] + v1[3] * v1[3]; } }
                if (!last) { part += __shfl_xor(part, 16); part += __shfl_xor(part, 32); if (fq == 0) ssq[(size_t)row * 16 + u.pn * 4 + wc] = part; } __builtin_amdgcn_sched_barrier(0); }
    }
};

struct EpiS5a {
    static constexpr bool PERM = true, AFTER_DRAIN = false;
    bf16_t* yloc; float* xend;
    __device__ __forceinline__ void operator()(const f32x4 (&acc)[2][2][4][2], const Unit& u, int wr, int wc, int fr, int fq) const {
        const int g = u.pm / 9, prow = u.pm - g * 9, pcol = u.pn - g * 3;
        const int rr0 = prow * BM + wr * 64 + fr, cc0 = wc * 32 + 8 * fq;
#pragma unroll
        for (int ai = 0; ai < 2; ++ai)
#pragma unroll
            for (int m = 0; m < 4; ++m) { const int rr = rr0 + ai * HALF + m * 16; const size_t grow = (size_t)g * S5ROWS + rr;
                if (pcol < 2) {
#pragma unroll
                    for (int bj = 0; bj < 2; ++bj) { const f32x4 v0 = acc[ai][bj][m][0], v1 = acc[ai][bj][m][1];
                        u32x4 w; w.x = cvt_pk_bf16(v0[0], v0[1]); w.y = cvt_pk_bf16(v0[2], v0[3]); w.z = cvt_pk_bf16(v1[0], v1[1]); w.w = cvt_pk_bf16(v1[2], v1[3]);
                        *(u32x4*)(yloc + grow * 512 + pcol * 256 + bj * HALF + cc0) = w; }
                } else { float* xp = xend + grow * 128 + cc0; *(f32x4*)xp = acc[ai][0][m][0]; *(f32x4*)(xp + 4) = acc[ai][0][m][1]; } }
    }
};

struct EpiS5b {
    static constexpr bool PERM = true, AFTER_DRAIN = false;
    const bf16_t* yloc; const bf16_t* proj; const float* dskip; bf16_t* ybuf;
    __device__ __forceinline__ void operator()(const f32x4 (&acc)[2][2][4][2], const Unit& u, int wr, int wc, int fr, int fq) const {
        const int g = u.pm / 9, prow = u.pm - g * 9, pcol = u.pn - g * 2;
        const int rr0 = prow * BM + wr * 64 + fr, cc0 = pcol * 256 + wc * 32 + 8 * fq;
#pragma unroll
        for (int ai = 0; ai < 2; ++ai)
#pragma unroll
            for (int m = 0; m < 4; ++m) { const int rr = rr0 + ai * HALF + m * 16; if (rr >= NBATCH * NCH32) continue;
                const int b = rr / NCH32, n = rr - b * NCH32; const size_t grow = (size_t)g * S5ROWS + rr;
#pragma unroll
                for (int bj = 0; bj < 2; ++bj) { const int cc = cc0 + bj * HALF, t = cc >> 4, c = cc & 15; const size_t trow = (size_t)b * LP + n * 32 + t;
                    float yl[8], uu[8], o[8]; unpack8(*(const u32x4*)(yloc + grow * 512 + cc), yl); unpack8(*(const u32x4*)(proj + trow * DINP + 2688 + 16 * g + c), uu);
                    const f32x4 d0 = *(const f32x4*)(dskip + 16 * g + c), d1 = *(const f32x4*)(dskip + 16 * g + c + 4);
#pragma unroll
                    for (int j = 0; j < 4; ++j) { o[j] = gelu_tanh(acc[ai][bj][m][0][j] + yl[j] + d0[j] * uu[j]); o[4 + j] = gelu_tanh(acc[ai][bj][m][1][j] + yl[4 + j] + d1[j] * uu[4 + j]); }
                    *(u32x4*)(ybuf + trow * 256 + 16 * g + c) = pack8(o); } __builtin_amdgcn_sched_barrier(0); }
    }
};

struct EpiGlu {
    static constexpr bool PERM = true, AFTER_DRAIN = false;
    const bf16_t* ybuf; bf16_t* mix;
    __device__ __forceinline__ void operator()(const f32x4 (&acc)[2][2][4][2], const Unit& u, int wr, int wc, int fr, int fq) const {
        const int row0 = u.pm * BM + wr * 64 + fr, col0 = wc * 32 + 8 * fq;
#pragma unroll
        for (int ai = 0; ai < 2; ++ai)
#pragma unroll
            for (int m = 0; m < 4; ++m) { const size_t row = row0 + ai * HALF + m * 16;
#pragma unroll
                for (int bj = 0; bj < 2; ++bj) { const int col = col0 + bj * HALF; float y[8], o[8]; unpack8(*(const u32x4*)(ybuf + row * 256 + col), y);
#pragma unroll
                    for (int j = 0; j < 4; ++j) { o[j] = y[j] * sigmoidf_(acc[ai][bj][m][0][j]); o[4 + j] = y[4 + j] * sigmoidf_(acc[ai][bj][m][1][j]); }
                    *(u32x4*)(mix + row * 1024 + 768 + col) = pack8(o); } __builtin_amdgcn_sched_barrier(0); }
    }
};

__device__ __forceinline__ void wtile(const float* W, int N, int k0, int n0, const float* gk, bf16_t* Wt, int ldk, int mode, float* tl) {
    const int tid = threadIdx.x;
#pragma unroll
    for (int i = 0; i < 8; ++i) { const int e = tid + 512 * i, kk = e >> 6, nn = e & 63; float v = W[(size_t)(k0 + kk) * N + n0 + nn]; if (gk) v *= gk[k0 + kk]; tl[kk * 65 + nn] = v; }
    __syncthreads();
    { const int nn = tid >> 3, kq = tid & 7, n = n0 + nn; float f[8];
#pragma unroll
      for (int e = 0; e < 8; ++e) f[e] = tl[(8 * kq + e) * 65 + nn];
      const int drow = mode == 0 ? n : ((n >> 7) * 256 + (mode == 2 ? 128 : 0) + (n & 127));
      *(u32x4*)(Wt + (size_t)drow * ldk + k0 + 8 * kq) = pack8(f); }
    __syncthreads();
}

__device__ __forceinline__ void phase_prep1(const Params& p, unsigned char* shm) {
    float* tl = (float*)shm;
    const int tid = tid_fresh(), nb = gridDim.x, bid = blockIdx.x;
    if (bid == 0 && tid < 64) ((unsigned*)(p.ws + OFF_CTR))[tid] = 0u;
    constexpr int T_IN = 16 * 46, T_OUT = 16 * 16, T_G = 16 * 44, T_D = 44 * 16, T_GLU = 16, T_L = T_IN + T_OUT + 2 * T_G + T_D + T_GLU;
    for (int it = bid; it < 2 * T_L; it += nb) {
        const int l = it / T_L; int r = it - l * T_L; unsigned char* wl = p.ws + OFF_W + (size_t)l * SZ_WL;
        if (r < T_IN) { wtile(p.w_in + (size_t)l * 1024 * 2944, 2944, (r / 46) * 64, (r % 46) * 64, p.norm1_g + l * 1024, (bf16_t*)(wl + WL_IN), 1024, 0, tl); continue; } r -= T_IN;
        if (r < T_OUT) { wtile(p.w_out + (size_t)l * 1024 * 1024, 1024, (r / 16) * 64, (r % 16) * 64, nullptr, (bf16_t*)(wl + WL_OUT), 1024, 0, tl); continue; } r -= T_OUT;
        if (r < T_G) { wtile(p.w_gate + (size_t)l * 1024 * DFF, DFF, (r / 44) * 64, (r % 44) * 64, p.norm2_g + l * 1024, (bf16_t*)(wl + WL_GU), 1024, 1, tl); continue; } r -= T_G;
        if (r < T_G) { wtile(p.w_up + (size_t)l * 1024 * DFF, DFF, (r / 44) * 64, (r % 44) * 64, p.norm2_g + l * 1024, (bf16_t*)(wl + WL_GU), 1024, 2, tl); continue; } r -= T_G;
        if (r < T_D) { wtile(p.w_down + (size_t)l * DFF * 1024, 1024, (r / 16) * 64, (r % 16) * 64, nullptr, (bf16_t*)(wl + WL_DN), DFF, 0, tl); continue; } r -= T_D;
        wtile(p.w_glu + (size_t)l * 256 * 256, 256, (r / 4) * 64, (r % 4) * 64, nullptr, (bf16_t*)(wl + WL_GLU), 256, 0, tl);
    }
    const size_t gtid = (size_t)bid * 512 + tid, gthreads = (size_t)nb * 512;
    for (size_t e = gtid; e < (size_t)2 * 128 * 128; e += gthreads) { const int l = (int)(e / (128 * 128)), q = (int)(e % (128 * 128));
        *(u32x4*)(p.ws + OFF_W + (size_t)l * SZ_WL + WL_IN + ((size_t)2944 * 1024 + (size_t)q * 8) * 2) = (u32x4){0u, 0u, 0u, 0u}; }
    { bf16_t* hb = (bf16_t*)(p.ws + OFF_HB); float* hmeta = (float*)(p.ws + OFF_HMETA); float* ssq = (float*)(p.ws + OFF_SSQ);
      const int wv = tid >> 6, lane = tid & 63;
      for (int row = bid * 8 + wv; row < MROWS; row += nb * 8) { const int b = row / LP, i = row - b * LP;
          const float* src = i < 112 ? nullptr : (i < 128 ? p.meta + (size_t)(i - 112) * 1024 : p.x + ((size_t)b * SEQ + (i - 128)) * 1024);
          float part = 0.f;
#pragma unroll
          for (int q = 0; q < 4; ++q) { const int c = q * 256 + lane * 4; f32x4 v = src ? *(const f32x4*)(src + c) : (f32x4){0.f, 0.f, 0.f, 0.f};
              part += v.x * v.x + v.y * v.y + v.z * v.z + v.w * v.w;
              u32x2 w; w.x = cvt_pk_bf16(v.x, v.y); w.y = cvt_pk_bf16(v.z, v.w); *(u32x2*)(hb + (size_t)row * 1024 + c) = w;
              if (i < 128) *(f32x4*)(hmeta + (size_t)(b * 128 + i) * 1024 + c) = v; }
#pragma unroll
          for (int o = 32; o >= 1; o >>= 1) part += __shfl_xor(part, o);
          if (lane < 16) ssq[(size_t)row * 16 + lane] = lane == 0 ? part : 0.f; } }
    { float* rot = (float*)(p.ws + OFF_ROT);
      for (size_t e = gtid; e < (size_t)LP * 32; e += gthreads) { const int i = (int)(e >> 5), f = (int)(e & 31);
          const float inv = powf(10000.0f, -(float)f / 32.0f), ang = (float)(i - 112) * inv; rot[2 * e] = cosf(ang); rot[2 * e + 1] = sinf(ang); } }
    for (size_t e = gtid; e < (size_t)2 * 16 * 64; e += gthreads) { const int l = (int)(e >> 10), gp = (int)(e & 1023), g = gp >> 6;
        const float lr = p.lam_re[l * 1024 + gp], li = p.lam_im[l * 1024 + gp], dt = expf(p.log_dt[l * 16 + g]);
        const float mag = expf(lr * dt), ar = mag * cosf(li * dt), ai = mag * sinf(li * dt), den = lr * lr + li * li;
        const float fr = ((ar - 1.0f) * lr + ai * li) / den, fi = (ai * lr - (ar - 1.0f) * li) / den;
        float* bb = (float*)(p.ws + OFF_S5P + (size_t)l * SZ_S5P + S5P_BB) + (size_t)gp * 32; float* pw = (float*)(p.ws + OFF_S5P + (size_t)l * SZ_S5P + S5P_PW) + (size_t)gp * 66;
        for (int c = 0; c < 16; ++c) { const float br = p.b_re[((size_t)l * 1024 + gp) * 16 + c], bi = p.b_im[((size_t)l * 1024 + gp) * 16 + c]; bb[2 * c] = fr * br - fi * bi; bb[2 * c + 1] = fr * bi + fi * br; }
        for (int d = 0; d <= 32; ++d) { const float mg = expf(lr * dt * (float)d), an = li * dt * (float)d; pw[2 * d] = mg * cosf(an); pw[2 * d + 1] = mg * sinf(an); } }
}

__device__ __forceinline__ void phase_prep2(const Params& p) {
    const size_t gtid = (size_t)blockIdx.x * 512 + tid_fresh(), gthreads = (size_t)gridDim.x * 512;
    for (size_t e = gtid; e < (size_t)2 * 16 * 32 * 256; e += gthreads) { const int l = (int)(e >> 17), g = (int)(e >> 13) & 15, d = (int)(e >> 8) & 31, c = (int)(e >> 4) & 15, c2 = (int)e & 15;
        const float* bb = (const float*)(p.ws + OFF_S5P + (size_t)l * SZ_S5P + S5P_BB) + (size_t)g * 64 * 32; const float* pw = (const float*)(p.ws + OFF_S5P + (size_t)l * SZ_S5P + S5P_PW) + (size_t)g * 64 * 66;
        const float* cr = p.c_re + ((size_t)(l * 16 + g) * 16 + c) * 64; const float* ci = p.c_im + ((size_t)(l * 16 + g) * 16 + c) * 64;
        float acc = 0.f;
        for (int s = 0; s < 64; ++s) { const float pr = pw[s * 66 + 2 * d], pi = pw[s * 66 + 2 * d + 1], br = bb[s * 32 + 2 * c2], bi = bb[s * 32 + 2 * c2 + 1];
            const float xr = pr * br - pi * bi, xi = pr * bi + pi * br; acc += cr[s] * xr - ci[s] * xi; }
        bf16_t* bt = (bf16_t*)(p.ws + OFF_S5M + (size_t)l * SZ_S5M + S5M_BT1) + (size_t)g * 768 * 512; const bf16_t v = f2bf(acc);
        for (int s = 0; s + d < 32; ++s) bt[(size_t)((s + d) * 16 + c) * 512 + s * 16 + c2] = v; }
    for (size_t e = gtid; e < (size_t)2 * 16 * 768 * 32; e += gthreads) { const int s = (int)(e & 31); const int row = (int)((e >> 5) % 768); const int lg = (int)(e / (768 * 32)), l = lg >> 4, g = lg & 15;
        bf16_t* dst = (bf16_t*)(p.ws + OFF_S5M + (size_t)l * SZ_S5M + S5M_BT1) + ((size_t)g * 768 + row) * 512 + s * 16; float f[16];
        if (row < 512) { if (s <= (row >> 4)) continue;
#pragma unroll
            for (int j = 0; j < 16; ++j) f[j] = 0.f; }
        else if (row < 640) { const int q = row - 512, pp = q & 63, im = q >> 6;
            const float* bb = (const float*)(p.ws + OFF_S5P + (size_t)l * SZ_S5P + S5P_BB) + (size_t)(g * 64 + pp) * 32; const float* pw = (const float*)(p.ws + OFF_S5P + (size_t)l * SZ_S5P + S5P_PW) + (size_t)(g * 64 + pp) * 66;
            const float pr = pw[2 * (31 - s)], pi = pw[2 * (31 - s) + 1];
#pragma unroll
            for (int j = 0; j < 16; ++j) { const float br = bb[2 * j], bi = bb[2 * j + 1]; f[j] = im ? (pr * bi + pi * br) : (pr * br - pi * bi); } }
        else {
#pragma unroll
            for (int j = 0; j < 16; ++j) f[j] = 0.f; }
        *(u32x4*)dst = pack8(f); *(u32x4*)(dst + 8) = pack8(f + 8); }
    for (size_t e = gtid; e < (size_t)2 * 16 * 512 * 32; e += gthreads) { const int qo = (int)(e & 31), row = (int)(e >> 5) & 511, lg = (int)(e >> 14), l = lg >> 4, g = lg & 15;
        const int t = row >> 4, c = row & 15; float f[8];
        const float* pw = (const float*)(p.ws + OFF_S5P + (size_t)l * SZ_S5P + S5P_PW) + (size_t)g * 64 * 66;
        const float* cr = p.c_re + ((size_t)(l * 16 + g) * 16 + c) * 64; const float* ci = p.c_im + ((size_t)(l * 16 + g) * 16 + c) * 64;
#pragma unroll
        for (int j = 0; j < 8; ++j) { const int q = qo * 8 + j; float v = 0.f;
            if (q < 128) { const int pp = q & 63; const float pr = pw[pp * 66 + 2 * (t + 1)], pi = pw[pp * 66 + 2 * (t + 1) + 1]; v = q < 64 ? (cr[pp] * pr - ci[pp] * pi) : -(cr[pp] * pi + ci[pp] * pr); }
            f[j] = v; }
        *(u32x4*)((bf16_t*)(p.ws + OFF_S5M + (size_t)l * SZ_S5M + S5M_E) + ((size_t)g * 512 + row) * 256 + qo * 8) = pack8(f); }
}

__device__ __forceinline__ float sum8(const float* f) { return f[0] * f[0] + f[1] * f[1] + f[2] * f[2] + f[3] * f[3] + f[4] * f[4] + f[5] * f[5] + f[6] * f[6] + f[7] * f[7]; }
__device__ __forceinline__ float red8(float v) { v += __shfl_xor(v, 1); v += __shfl_xor(v, 2); v += __shfl_xor(v, 4); return v; }
__device__ __forceinline__ void tile_put(bf16_t* T, int tok, int j, u32x4 w) { unsigned* q = (unsigned*)(T + tok * 66 + 8 * j); q[0] = w.x; q[1] = w.y; q[2] = w.z; q[3] = w.w; }
__device__ __forceinline__ u32x4 tile_get_t(const bf16_t* T, int d, int tj) { unsigned short v[8];
#pragma unroll
    for (int e = 0; e < 8; ++e) v[e] = T[(8 * tj + e) * 66 + d];
    u32x4 w; w.x = v[0] | ((unsigned)v[1] << 16); w.y = v[2] | ((unsigned)v[3] << 16); w.z = v[4] | ((unsigned)v[5] << 16); w.w = v[6] | ((unsigned)v[7] << 16); return w; }

__device__ __forceinline__ void phase_a2(const Params& p, int l, unsigned char* shm) {
    bf16_t* proj = (bf16_t*)(p.ws + OFF_PROJ); bf16_t* T0 = (bf16_t*)shm; bf16_t* T1 = T0 + 64 * 66;
    bf16_t* vst = (bf16_t*)(p.ws + OFF_VST); bf16_t* vrt = (bf16_t*)(p.ws + OFF_VRT); bf16_t* krt = (bf16_t*)(p.ws + OFF_KRT); bf16_t* ure = (bf16_t*)(p.ws + OFF_URE);
    const float* rot = (const float*)(p.ws + OFF_ROT);
    const int tid = tid_fresh(), tok = tid >> 3, j = tid & 7;
#pragma unroll 1
    for (int item = blockIdx.x; item < (MROWS / 64) * 13; item += gridDim.x) {
        const int tile = item / 13, slot = item - tile * 13, r0 = tile * 64, b = r0 / LP, i0 = r0 - b * LP, r = r0 + tok, i = i0 + tok;
        bf16_t* prow = proj + (size_t)r * DINP;
        if (slot < 6) { const int h = slot; float f[8];
            { unpack8(*(const u32x4*)(prow + 64 * h + 8 * j), f); const float inv = rsqrtf(red8(sum8(f)) * (1.0f / 64.0f) + RMS_EPS) * (0.125f * LOG2E);
#pragma unroll
              for (int e = 0; e < 8; ++e) f[e] *= inv * p.sb_q_g[l * 64 + 8 * j + e];
              *(u32x4*)(prow + 64 * h + 8 * j) = pack8(f); }
            { unpack8(*(const u32x4*)(prow + 384 + 64 * h + 8 * j), f); const float inv = rsqrtf(red8(sum8(f)) * (1.0f / 64.0f) + RMS_EPS);
#pragma unroll
              for (int e = 0; e < 8; ++e) f[e] *= inv * p.sb_k_g[l * 64 + 8 * j + e];
              *(u32x4*)(prow + 384 + 64 * h + 8 * j) = pack8(f); }
            tile_put(T0, tok, j, *(const u32x4*)(prow + 768 + 64 * h + 8 * j));
            __syncthreads();
            *(u32x4*)(vst + ((size_t)(b * 6 + h) * 64 + tok) * LP + i0 + 8 * j) = tile_get_t(T0, tok, j);
            __syncthreads();
        } else if (slot < 12) { const int h = slot - 6; float f[8], o[8];
            const float lg = log_gamma_h(h), ex = lg * (float)((i & 127) + 1), qd = __expf(ex), kd = 0.125f * __expf(-ex);
            const float* cs = rot + ((size_t)i * 32 + 8 * (j & 3)) * 2;
            { unpack8(*(const u32x4*)(prow + 1152 + 64 * h + 8 * j), f); const float inv = rsqrtf(red8(sum8(f)) * (1.0f / 64.0f) + RMS_EPS);
#pragma unroll
              for (int e = 0; e < 8; ++e) f[e] *= inv * p.ret_q_g[l * 64 + 8 * j + e];
#pragma unroll
              for (int e = 0; e < 8; ++e) { const float other = __shfl_xor(f[e], 4), c = cs[2 * e], s = cs[2 * e + 1]; o[e] = (j < 4 ? f[e] * c - other * s : other * s + f[e] * c) * qd; }
              *(u32x4*)(prow + 1152 + 64 * h + 8 * j) = pack8(o); }
            { unpack8(*(const u32x4*)(prow + 1536 + 64 * h + 8 * j), f); const float inv = rsqrtf(red8(sum8(f)) * (1.0f / 64.0f) + RMS_EPS);
#pragma unroll
              for (int e = 0; e < 8; ++e) f[e] *= inv * p.ret_k_g[l * 64 + 8 * j + e];
#pragma unroll
              for (int e = 0; e < 8; ++e) { const float other = __shfl_xor(f[e], 4), c = cs[2 * e], s = cs[2 * e + 1]; o[e] = (j < 4 ? f[e] * c - other * s : other * s + f[e] * c) * kd; }
              const u32x4 w = pack8(o); *(u32x4*)(prow + 1536 + 64 * h + 8 * j) = w; tile_put(T1, tok, j, w); }
            tile_put(T0, tok, j, *(const u32x4*)(prow + 1920 + 64 * h + 8 * j));
            __syncthreads();
            *(u32x4*)(vrt + ((size_t)(b * 6 + h) * 64 + tok) * LP + i0 + 8 * j) = tile_get_t(T0, tok, j);
            *(u32x4*)(krt + ((size_t)(b * 6 + h) * 64 + tok) * LP + i0 + 8 * j) = tile_get_t(T1, tok, j);
            __syncthreads();
        } else {
#pragma unroll
            for (int gi = 0; gi < 2; ++gi) { const int g = 2 * j + gi; const u32x4 a = *(const u32x4*)(prow + 2688 + 16 * g), c = *(const u32x4*)(prow + 2688 + 16 * g + 8);
                bf16_t* dst = ure + ((size_t)g * S5ROWS + b * NCH32 + (i >> 5)) * 512 + (i & 31) * 16; *(u32x4*)dst = a; *(u32x4*)(dst + 8) = c; }
        }
    }
}

__device__ __forceinline__ bf16x8 ld16(const bf16_t* q) { return *(const bf16x8*)q; }
__device__ __forceinline__ bf16x8 ld8x2(const bf16_t* a, const bf16_t* b) { const bf16x4 x = *(const bf16x4*)a, y = *(const bf16x4*)b; bf16x8 r; r[0] = x[0]; r[1] = x[1]; r[2] = x[2]; r[3] = x[3]; r[4] = y[0]; r[5] = y[1]; r[6] = y[2]; r[7] = y[3]; return r; }
__device__ __forceinline__ bf16x8 pk8(const f32x16& v, int s) { u32x4 w; w.x = cvt_pk_bf16(v[8 * s + 0], v[8 * s + 1]); w.y = cvt_pk_bf16(v[8 * s + 2], v[8 * s + 3]); w.z = cvt_pk_bf16(v[8 * s + 4], v[8 * s + 5]); w.w = cvt_pk_bf16(v[8 * s + 6], v[8 * s + 7]);
    bf16x8 r; __builtin_memcpy(&r, &w, 16); return r; }

__device__ __forceinline__ void sb_wave(const Params& p, int widx) {
    const bf16_t* proj = (const bf16_t*)(p.ws + OFF_PROJ); const bf16_t* vst = (const bf16_t*)(p.ws + OFF_VST); bf16_t* mix = (bf16_t*)(p.ws + OFF_MIX);
    const int qt = widx % NCH32, bh = widx / NCH32, b = bh / 6, h = bh - b * 6, lane = tid_fresh() & 63, r = lane & 31, hh = lane >> 5;
    const size_t row0 = (size_t)b * LP + qt * 32; bf16_t* orow = mix + (row0 + r) * 1024 + 64 * h;
    if (qt < 3) {
#pragma unroll
        for (int q = 0; q < 4; ++q) *(u32x4*)(orow + 32 * hh + 8 * q) = (u32x4){0u, 0u, 0u, 0u};
        return; }
    bf16x8 qf[4];
#pragma unroll
    for (int s = 0; s < 4; ++s) qf[s] = ld16(proj + (row0 + r) * DINP + 64 * h + 16 * s + 8 * hh);
    f32x16 o0, o1;
#pragma unroll
    for (int e = 0; e < 16; ++e) { o0[e] = 0.f; o1[e] = 0.f; }
    float carry = 1.0f; const int qi = qt * 32 + r; const bf16_t* vb = vst + (size_t)bh * 64 * LP;
#pragma unroll 1
    for (int kt = qt; kt >= 3; --kt) {
        const size_t krow0 = (size_t)b * LP + kt * 32;
        f32x16 st;
#pragma unroll
        for (int e = 0; e < 16; ++e) st[e] = 0.f;
#pragma unroll
        for (int s = 0; s < 4; ++s) st = MFMA32(ld16(proj + (krow0 + r) * DINP + 384 + 64 * h + 16 * s + 8 * hh), qf[s], st);
        float T[4];
#pragma unroll
        for (int jj = 0; jj < 4; ++jj) { float suf = 1.0f;
#pragma unroll
            for (int kk = 3; kk >= 0; --kk) { const int reg = 4 * jj + kk, key = kt * 32 + 8 * jj + 4 * hh + kk; const bool valid = key < qi && key >= 112;
                const float ez = valid ? __builtin_amdgcn_exp2f(fminf(st[reg], 100.0f)) : 0.0f; st[reg] = ez; suf *= 1.0f + ez; }
            T[jj] = suf; }
        float Tp[4], PP[4], tail[4];
#pragma unroll
        for (int jj = 0; jj < 4; ++jj) { Tp[jj] = __shfl_xor(T[jj], 32); PP[jj] = T[jj] * Tp[jj]; }
        tail[3] = 1.0f; tail[2] = PP[3]; tail[1] = PP[2] * tail[2]; tail[0] = PP[1] * tail[1];
        f32x16 w;
#pragma unroll
        for (int jj = 0; jj < 4; ++jj) { const float after = carry * tail[jj] * (hh == 0 ? Tp[jj] : 1.0f); float suf = 1.0f;
#pragma unroll
            for (int kk = 3; kk >= 0; --kk) { const int reg = 4 * jj + kk; const float e = st[reg]; suf *= 1.0f + e; w[reg] = e * __builtin_amdgcn_rcpf(after * suf); } }
        carry = carry * PP[0] * tail[0];
        const bf16x8 p0 = pk8(w, 0), p1 = pk8(w, 1);
        const bf16_t* v0 = vb + (size_t)r * LP + kt * 32 + 4 * hh; const bf16_t* v1 = v0 + (size_t)32 * LP;
        o0 = MFMA32(ld8x2(v0, v0 + 8), p0, o0); o0 = MFMA32(ld8x2(v0 + 16, v0 + 24), p1, o0);
        o1 = MFMA32(ld8x2(v1, v1 + 8), p0, o1); o1 = MFMA32(ld8x2(v1 + 16, v1 + 24), p1, o1);
        if (__all(carry > 1.0995e12f)) break;
    }
#pragma unroll
    for (int jj = 0; jj < 4; ++jj) { u32x2 a, c; a.x = cvt_pk_bf16(o0[4 * jj], o0[4 * jj + 1]); a.y = cvt_pk_bf16(o0[4 * jj + 2], o0[4 * jj + 3]); c.x = cvt_pk_bf16(o1[4 * jj], o1[4 * jj + 1]); c.y = cvt_pk_bf16(o1[4 * jj + 2], o1[4 * jj + 3]);
        *(u32x2*)(orow + 8 * jj + 4 * hh) = a; *(u32x2*)(orow + 32 + 8 * jj + 4 * hh) = c; }
}

__device__ __forceinline__ void ret_item(const Params& p, int l, int bh, unsigned char* shm) {
    const bf16_t* proj = (const bf16_t*)(p.ws + OFF_PROJ); const bf16_t* vrt = (const bf16_t*)(p.ws + OFF_VRT) + (size_t)bh * 64 * LP; const bf16_t* krt = (const bf16_t*)(p.ws + OFF_KRT) + (size_t)bh * 64 * LP;
    bf16_t* mix = (bf16_t*)(p.ws + OFF_MIX);
    const int b = bh / 6, h = bh - b * 6, tid = tid_fresh(), wv = tid >> 6, lane = tid & 63, r = lane & 31, hh = lane >> 5;
    bf16_t* ST = (bf16_t*)shm;
    for (int e = tid; e < 2 * 64 * 72 / 2; e += 512) ((unsigned*)ST)[e] = 0u;
    __syncthreads();
    const float lg = log_gamma_h(h), cdec = __expf(lg * 128.0f);
    f32x16 sacc;
#pragma unroll
    for (int e = 0; e < 16; ++e) sacc[e] = 0.f;
#pragma unroll 1
    for (int n = 0; n < LP / 128; ++n) {
        const bf16_t* Sc = ST + (n & 1) * 64 * 72; bf16_t* Sn = ST + ((n & 1) ^ 1) * 64 * 72;
        if (wv < 4) {
            const size_t row0 = (size_t)b * LP + n * 128 + 32 * wv;
            bf16x8 qf[4];
#pragma unroll
            for (int s = 0; s < 4; ++s) qf[s] = ld16(proj + (row0 + r) * DINP + 1152 + 64 * h + 16 * s + 8 * hh);
            f32x16 o0, o1;
#pragma unroll
            for (int e = 0; e < 16; ++e) { o0[e] = 0.f; o1[e] = 0.f; }
#pragma unroll
            for (int s = 0; s < 4; ++s) { o0 = MFMA32(*(const bf16x8*)(Sc + r * 72 + 16 * s + 8 * hh), qf[s], o0); o1 = MFMA32(*(const bf16x8*)(Sc + (32 + r) * 72 + 16 * s + 8 * hh), qf[s], o1); }
#pragma unroll 1
            for (int kt = 0; kt <= wv; ++kt) {
                const size_t krow0 = (size_t)b * LP + n * 128 + 32 * kt;
                f32x16 st;
#pragma unroll
                for (int e = 0; e < 16; ++e) st[e] = 0.f;
#pragma unroll
                for (int s = 0; s < 4; ++s) st = MFMA32(ld16(proj + (krow0 + r) * DINP + 1536 + 64 * h + 16 * s + 8 * hh), qf[s], st);
                if (kt == wv) {
#pragma unroll
                    for (int reg = 0; reg < 16; ++reg) { const int key = 8 * (reg >> 2) + 4 * hh + (reg & 3); st[reg] = key <= r ? st[reg] : 0.f; } }
                const bf16x8 p0 = pk8(st, 0), p1 = pk8(st, 1);
                const bf16_t* v0 = vrt + (size_t)r * LP + n * 128 + kt * 32 + 4 * hh; const bf16_t* v1 = v0 + (size_t)32 * LP;
                o0 = MFMA32(ld8x2(v0, v0 + 8), p0, o0); o0 = MFMA32(ld8x2(v0 + 16, v0 + 24), p1, o0);
                o1 = MFMA32(ld8x2(v1, v1 + 8), p0, o1); o1 = MFMA32(ld8x2(v1 + 16, v1 + 24), p1, o1);
            }
            float ss = 0.f;
#pragma unroll
            for (int e = 0; e < 16; ++e) ss += o0[e] * o0[e] + o1[e] * o1[e];
            ss += __shfl_xor(ss, 32);
            const float inv = rsqrtf(ss * (1.0f / 64.0f) + RMS_EPS);
            const bf16_t* grow = proj + (row0 + r) * DINP + 2304 + 64 * h; bf16_t* orow = mix + (row0 + r) * 1024 + 384 + 64 * h; const float* og = p.ret_out_g + l * 384 + 64 * h;
#pragma unroll
            for (int t2 = 0; t2 < 2; ++t2)
#pragma unroll
                for (int jj = 0; jj < 4; ++jj) { const int e0 = 32 * t2 + 8 * jj + 4 * hh; const u32x2 gw = *(const u32x2*)(grow + e0); const f32x4 gg = *(const f32x4*)(og + e0);
                    const float g0 = lo_bf(gw.x), g1 = hi_bf(gw.x), g2 = lo_bf(gw.y), g3 = hi_bf(gw.y);
                    const float a0 = (t2 ? o1[4 * jj] : o0[4 * jj]) * inv * gg[0] * g0 * sigmoidf_(g0), a1 = (t2 ? o1[4 * jj + 1] : o0[4 * jj + 1]) * inv * gg[1] * g1 * sigmoidf_(g1);
                    const float a2 = (t2 ? o1[4 * jj + 2] : o0[4 * jj + 2]) * inv * gg[2] * g2 * sigmoidf_(g2), a3 = (t2 ? o1[4 * jj + 3] : o0[4 * jj + 3]) * inv * gg[3] * g3 * sigmoidf_(g3);
                    u32x2 w; w.x = cvt_pk_bf16(a0, a1); w.y = cvt_pk_bf16(a2, a3); *(u32x2*)(orow + e0) = w; }
        } else {
            const int di = (wv - 4) >> 1, ei = (wv - 4) & 1;
            const bf16_t* kp = krt + (size_t)(32 * di + r) * LP + n * 128 + 8 * hh; const bf16_t* vp = vrt + (size_t)(32 * ei + r) * LP + n * 128 + 8 * hh;
#pragma unroll
            for (int s = 0; s < 8; ++s) sacc = MFMA32(ld16(kp + 16 * s), ld16(vp + 16 * s), sacc);
#pragma unroll
            for (int e = 0; e < 16; ++e) sacc[e] *= cdec;
#pragma unroll
            for (int jj = 0; jj < 4; ++jj) { u32x2 w; w.x = cvt_pk_bf16(sacc[4 * jj], sacc[4 * jj + 1]); w.y = cvt_pk_bf16(sacc[4 * jj + 2], sacc[4 * jj + 3]);
                *(u32x2*)(Sn + (32 * ei + r) * 72 + 32 * di + 8 * jj + 4 * hh) = w; }
        }
        __syncthreads();
    }
}

__device__ __forceinline__ void phase_b_items(const Params& p, int l, unsigned char* shm) {
    __shared__ int s_item;
    unsigned* ctr = (unsigned*)(p.ws + OFF_CTR) + l;
    constexpr int N_RET = NBATCH * 6, N_SB = NBATCH * 6 * NCH32 / 8;
#pragma unroll 1
    for (;;) {
        __syncthreads();
        if (threadIdx.x == 0) s_item = (int)atomicAdd(ctr, 1u);
        __syncthreads();
        const int item = s_item;
        if (item >= N_RET + N_SB) break;
        if (item < N_RET) ret_item(p, l, item, shm);
        else sb_wave(p, (item - N_RET) * 8 + (tid_fresh() >> 6));
    }
}

__device__ __forceinline__ void phase_s5_scan(const Params& p, int l) {
    const int gt = blockIdx.x * 512 + tid_fresh(); if (gt >= 16 * 16 * 64) return;
    const int pp = gt & 63, b = (gt >> 6) & 15, g = gt >> 10;
    const float* pw = (const float*)(p.ws + OFF_S5P + (size_t)l * SZ_S5P + S5P_PW) + (size_t)(g * 64 + pp) * 66; const float ar = pw[64], ai = pw[65];
    const float* xe = (const float*)(p.ws + OFF_XEND) + ((size_t)g * S5ROWS + b * NCH32) * 128; bf16_t* xs = (bf16_t*)(p.ws + OFF_XST) + ((size_t)g * S5ROWS + b * NCH32) * 256;
    float xr = 0.f, xi = 0.f;
#pragma unroll 4
    for (int n = 0; n < NCH32; ++n) { xs[n * 256 + pp] = f2bf(xr); xs[n * 256 + 64 + pp] = f2bf(xi); xs[n * 256 + 128 + pp] = 0; xs[n * 256 + 192 + pp] = 0;
        const float er = xe[n * 128 + pp], ei = xe[n * 128 + 64 + pp]; const float nr = ar * xr - ai * xi + er, ni = ar * xi + ai * xr + ei; xr = nr; xi = ni; }
}

__device__ __forceinline__ Params fresh(Params p) { asm volatile("" : "+s"(p.ws), "+s"(p.out), "+s"(p.x)); return p; }
__global__ void __launch_bounds__(512, 2) hymba_fwd(Params p0) {
    extern __shared__ __attribute__((aligned(16))) unsigned char shm[];
    cg::grid_group grid = cg::this_grid();
    PG8_LAS unsigned char* lds = (PG8_LAS unsigned char*)shm;
    phase_prep1(fresh(p0), shm);
    grid.sync();
    phase_prep2(fresh(p0));
    grid.sync();
#pragma unroll 1
    for (int l0 = 0; l0 < 2; ++l0) {
        { const Params p = fresh(p0); const int l = sgpr_fresh(l0), G = sgpr_fresh((int)gridDim.x), c = sgpr_fresh((int)blockIdx.x); const unsigned char* wl = p.ws + OFF_W + (size_t)l * SZ_WL;
          StaticOrder S; S.init(MROWS, DINP, G, c); EpiProj E{(bf16_t*)(p.ws + OFF_PROJ), (const float*)(p.ws + OFF_SSQ)};
          gemm_phase<EpiProj, StaticOrder>(lds, Gemm{(const bf16_t*)(p.ws + OFF_HB), (const bf16_t*)(wl + WL_IN), MROWS, DINP, 1024}, S, E, nullptr); }
        grid.sync();
        phase_a2(fresh(p0), sgpr_fresh(l0), shm);
        grid.sync();
        { const Params p = fresh(p0); const int l = sgpr_fresh(l0), G = sgpr_fresh((int)gridDim.x), c = sgpr_fresh((int)blockIdx.x); const unsigned char* sm = p.ws + OFF_S5M + (size_t)l * SZ_S5M;
          BatchedOrder S; S.init(16, 9, 3, G, c); EpiS5a E{(bf16_t*)(p.ws + OFF_YLOC), (float*)(p.ws + OFF_XEND)};
          gemm_phase<EpiS5a, BatchedOrder>(lds, Gemm{(const bf16_t*)(p.ws + OFF_URE), (const bf16_t*)(sm + S5M_BT1), 16 * S5ROWS, 16 * 768, 512}, S, E, nullptr); }
        __syncthreads();
        phase_b_items(fresh(p0), sgpr_fresh(l0), shm);
        grid.sync();
        phase_s5_scan(fresh(p0), sgpr_fresh(l0));
        grid.sync();
        { const Params p = fresh(p0); const int l = sgpr_fresh(l0), G = sgpr_fresh((int)gridDim.x), c = sgpr_fresh((int)blockIdx.x); const unsigned char* sm = p.ws + OFF_S5M + (size_t)l * SZ_S5M;
          BatchedOrder S; S.init(16, 9, 2, G, c); EpiS5b E{(const bf16_t*)(p.ws + OFF_YLOC), (const bf16_t*)(p.ws + OFF_PROJ), p.s5_d + l * 256, (bf16_t*)(p.ws + OFF_YBUF)};
          gemm_phase<EpiS5b, BatchedOrder>(lds, Gemm{(const bf16_t*)(p.ws + OFF_XST), (const bf16_t*)(sm + S5M_E), 16 * S5ROWS, 16 * 512, 256}, S, E, nullptr); }
        grid.sync();
        { const Params p = fresh(p0); const int l = sgpr_fresh(l0), G = sgpr_fresh((int)gridDim.x), c = sgpr_fresh((int)blockIdx.x); const unsigned char* wl = p.ws + OFF_W + (size_t)l * SZ_WL;
          StaticOrder S; S.init(MROWS, 256, G, c); EpiGlu E{(const bf16_t*)(p.ws + OFF_YBUF), (bf16_t*)(p.ws + OFF_MIX)};
          gemm_phase<EpiGlu, StaticOrder>(lds, Gemm{(const bf16_t*)(p.ws + OFF_YBUF), (const bf16_t*)(wl + WL_GLU), MROWS, 256, 256}, S, E, nullptr); }
        grid.sync();
        { const Params p = fresh(p0); const int l = sgpr_fresh(l0), G = sgpr_fresh((int)gridDim.x), c = sgpr_fresh((int)blockIdx.x); const unsigned char* wl = p.ws + OFF_W + (size_t)l * SZ_WL;
          float* hmeta = (float*)(p.ws + OFF_HMETA);
          StaticOrder S; S.init(MROWS, 1024, G, c); EpiRes E{l == 0 ? p.x : p.out, hmeta, p.out, hmeta, (bf16_t*)(p.ws + OFF_HB), (float*)(p.ws + OFF_SSQ), 0};
          gemm_phase<EpiRes, StaticOrder>(lds, Gemm{(const bf16_t*)(p.ws + OFF_MIX), (const bf16_t*)(wl + WL_OUT), MROWS, 1024, 1024}, S, E, nullptr); }
        grid.sync();
        { const Params p = fresh(p0); const int l = sgpr_fresh(l0), G = sgpr_fresh((int)gridDim.x), c = sgpr_fresh((int)blockIdx.x); const unsigned char* wl = p.ws + OFF_W + (size_t)l * SZ_WL;
          StaticOrder S; S.init(MROWS, 5632, G, c); EpiAct E{(bf16_t*)(p.ws + OFF_ACT), (const float*)(p.ws + OFF_SSQ)};
          gemm_phase<EpiAct, StaticOrder>(lds, Gemm{(const bf16_t*)(p.ws + OFF_HB), (const bf16_t*)(wl + WL_GU), MROWS, 5632, 1024}, S, E, nullptr); }
        grid.sync();
        { const Params p = fresh(p0); const int l = sgpr_fresh(l0), G = sgpr_fresh((int)gridDim.x), c = sgpr_fresh((int)blockIdx.x); const unsigned char* wl = p.ws + OFF_W + (size_t)l * SZ_WL;
          float* hmeta = (float*)(p.ws + OFF_HMETA);
          StaticOrder S; S.init(MROWS, 1024, G, c); EpiRes E{p.out, hmeta, p.out, hmeta, (bf16_t*)(p.ws + OFF_HB), (float*)(p.ws + OFF_SSQ), l == 1 ? 1 : 0};
          gemm_phase<EpiRes, StaticOrder>(lds, Gemm{(const bf16_t*)(p.ws + OFF_ACT), (const bf16_t*)(wl + WL_DN), MROWS, 1024, DFF}, S, E, nullptr); }
        grid.sync();
    }
}

extern "C" void kernel_launch(void* const* d_in, const int* in_sizes, int n_in, void* d_out, int out_size, void* d_ws, size_t ws_size, hipStream_t stream) {
    constexpr size_t kDynLds = STAGE_BYTES;
    static int grid_blocks = 0;
    if (!grid_blocks) {
        hipFuncSetAttribute((const void*)hymba_fwd, hipFuncAttributeMaxDynamicSharedMemorySize, (int)kDynLds);
        int dev = 0, cus = 0, per_cu = 0;
        hipGetDevice(&dev);
        hipDeviceGetAttribute(&cus, hipDeviceAttributeMultiprocessorCount, dev);
        hipOccupancyMaxActiveBlocksPerMultiprocessor(&per_cu, hymba_fwd, 512, kDynLds);
        if (per_cu > 1) per_cu = 1;
        grid_blocks = cus * per_cu;
    }
    Params p{};
    const float** f = (const float**)&p;
    for (int i = 0; i < 23; ++i) f[i] = (const float*)d_in[i];
    p.out = (float*)d_out; p.ws = (unsigned char*)d_ws;
    void* args[] = {&p};
    hipError_t e = hipLaunchCooperativeKernel((void*)hymba_fwd, dim3(grid_blocks), dim3(512), args, kDynLds, stream);
    if (e != hipSuccess) fprintf(stderr, "cooperative launch failed: %s (grid %d)\n", hipGetErrorString(e), grid_blocks);
}
```

```cpp
#include <hip/hip_runtime.h>
#include <hip/hip_cooperative_groups.h>
#include <cstdio>
namespace cg = cooperative_groups;
#ifndef DUP_MASK
#define DUP_MASK 0
#endif
#ifndef DUP_NOP
#define DUP_NOP 0
#endif
#ifndef B_ONLY
#define B_ONLY 0
#endif
#ifndef EXTRA_SYNCS
#define EXTRA_SYNCS 0
#endif

namespace pg8 {
#define PG8_LAS __attribute__((address_space(3)))
typedef unsigned short bf16_t;
typedef short bf16x8 __attribute__((ext_vector_type(8)));
typedef float f32x4 __attribute__((ext_vector_type(4)));
typedef unsigned u32x4 __attribute__((ext_vector_type(4)));
__device__ __forceinline__ int tid_fresh() { int t = threadIdx.x; asm volatile("" : "+v"(t)); return t; }
__device__ __forceinline__ int sgpr_fresh(int v) { asm volatile("" : "+s"(v)); return v; }
constexpr int BM = 256, BK = 64, HALF = 128, HTB = HALF * BK * 2  , STAGE_BYTES = 8 * HTB, NXCD = 8, WGM = 8;

__host__ __device__ __forceinline__ int lds_byte(int r, int c) { const int st = (r >> 4) * 2 + (c >> 5), rr = r & 15, cc = c & 31, ob = rr * 64 + cc * 2; return st * 1024 + (ob ^ (((ob >> 9) & 1) << 5)); }
__host__ __device__ __forceinline__ void stage_rc(int b, int& R, int& C) { const int st = b / 1024, sb = b % 1024, swz = sb ^ (((sb >> 9) & 1) << 5); R = (st >> 1) * 16 + swz / 64; C = (st & 1) * 32 + (swz % 64) / 2; }
__host__ __device__ __forceinline__ int perm32(int rho) { const int n = rho >> 4, i = rho & 15; return 8 * (i >> 2) + 4 * n + (i & 3); }

struct Unit { int pm, pn; };
struct Gemm { const bf16_t* A; const bf16_t* Bt; int M, N, K; };

struct StaticOrder {
    int nM, nN, nwg, G, c;
    __host__ __device__ void init(int M, int N, int G_, int c_) { nM = M / BM; nN = N / BM; nwg = nM * nN; G = G_; c = c_; }
    __host__ __device__ bool next(int i, Unit& u) const {
        const long L = (long)i * G + c; if (L >= nwg) return false;
        int wgid = (int)L; { const int q = nwg / NXCD, r = nwg % NXCD, xcd = wgid % NXCD, off = wgid / NXCD; wgid = (xcd < r ? xcd * (q + 1) : r * (q + 1) + (xcd - r) * q) + off; }
        const int nig = WGM * nN, gid = wgid / nig, fm = gid * WGM, gsz = (nM - fm) < WGM ? (nM - fm) : WGM;
        u.pm = fm + ((wgid % nig) % gsz); u.pn = (wgid % nig) / gsz; return true;
    }
    __device__ __forceinline__ void a_ready(const Unit&) const {}
    __device__ __forceinline__ void done(const Unit&) const {}
};
__device__ __forceinline__ unsigned cvt_pk_bf16(float lo, float hi) { unsigned r; asm volatile("v_cvt_pk_bf16_f32 %0, %1, %2" : "=v"(r) : "v"(lo), "v"(hi)); return r; }

template <class Epi, class Sched, bool STAMP = false>
__device__ __forceinline__ void gemm_phase(PG8_LAS unsigned char* lds, const Gemm g, const Sched& S, const Epi& E, unsigned long long* stamps) {
    const int tid = tid_fresh(), wid = __builtin_amdgcn_readfirstlane(tid >> 6), lane = tid & 63, wr = wid >> 2, wc = wid & 3, fr = lane & 15, fq = lane >> 4;
    const int K = g.K, nt = K / BK;
    int ts_lo = 0, ts_hi = 0, nts = 0; const unsigned long long rt_entry = STAMP ? (unsigned long long)wall_clock64() : 0ull;
#define PG8_STAMP() do { if (STAMP && wid == 0 && nts < 64) { const unsigned long long _c = (unsigned long long)clock64(); \
        ts_lo = (lane == nts) ? (int)(unsigned)_c : ts_lo; ts_hi = (lane == nts) ? (int)(unsigned)(_c >> 32) : ts_hi; ++nts; } } while (0)
    PG8_STAMP();
    unsigned voffA[2], voffB[2];
#pragma unroll
    for (int i = 0; i < 2; ++i) { int R, C; stage_rc(tid * 16 + i * 8192, R, C); const int Rb = Epi::PERM ? ((R & ~31) + perm32(R & 31)) : R;
        voffA[i] = (unsigned)(R * K + C) * 2u; voffB[i] = (unsigned)(Rb * K + C) * 2u; }
    const size_t kstep = (size_t)(BK * 2);
    const size_t hstep = (size_t)HALF * K * 2;
    const size_t tstep = 2 * hstep;
    const unsigned ldsw = (unsigned)wid * 1024u;
    const int aoff = lds_byte(wr * 64 + fr, fq * 8), boff = lds_byte(wc * 32 + fr, fq * 8);
#define PG8_SA(b, h) (((b) * 2 + (h)) * HTB)
#define PG8_SB(b, h) ((4 + (b) * 2 + (h)) * HTB)
#define PG8_STAGE(bufoff, gbase, voff) do { _Pragma("unroll") for (int _i = 0; _i < 2; ++_i) \
        __builtin_amdgcn_global_load_lds((const unsigned*)((const char*)(gbase) + (voff)[_i]), (PG8_LAS unsigned*)(lds + (bufoff) + ldsw + _i * 8192), 16, 0, 0); } while (0)
#define PG8_LDA(dst, b, h) do { _Pragma("unroll") for (int m = 0; m < 4; ++m) _Pragma("unroll") for (int k = 0; k < 2; ++k) dst[m][k] = *(const PG8_LAS bf16x8*)(lds + PG8_SA(b, h) + aoff + m * 2048 + k * 1024); } while (0)
#define PG8_LDB(dst, b, h) do { _Pragma("unroll") for (int n = 0; n < 2; ++n) _Pragma("unroll") for (int k = 0; k < 2; ++k) dst[n][k] = *(const PG8_LAS bf16x8*)(lds + PG8_SB(b, h) + boff + n * 2048 + k * 1024); } while (0)
#define PG8_MMA(ai, bj, At, Bt) do { __builtin_amdgcn_s_setprio(1); _Pragma("unroll") for (int m = 0; m < 4; ++m) _Pragma("unroll") for (int n = 0; n < 2; ++n) _Pragma("unroll") for (int k = 0; k < 2; ++k) \
        acc[ai][bj][m][n] = __builtin_amdgcn_mfma_f32_16x16x32_bf16(Bt[n][k], At[m][k], acc[ai][bj][m][n], 0, 0, 0); __builtin_amdgcn_s_setprio(0); } while (0)
#define PG8_WAIT_V(n) asm volatile("s_waitcnt vmcnt(" #n ")" ::: "memory")
#define PG8_WAIT_L(n) asm volatile("s_waitcnt lgkmcnt(" #n ")" ::: "memory")
#define PG8_BAR __builtin_amdgcn_s_barrier()
#define PG8_SCHED __builtin_amdgcn_sched_barrier(0)
    Unit cur, nxt; int ui = 0;
    if (!S.next(0, cur)) return;
    f32x4 acc[2][2][4][2];
#pragma unroll
    for (int a = 0; a < 2; ++a)
#pragma unroll
        for (int b = 0; b < 2; ++b)
#pragma unroll
            for (int m = 0; m < 4; ++m)
#pragma unroll
                for (int n = 0; n < 2; ++n) acc[a][b][m][n] = (f32x4){0.f, 0.f, 0.f, 0.f};
    bf16x8 At[4][2], B0[2][2], B1[2][2];
    const char* cA = (const char*)g.A + (size_t)cur.pm * tstep; const char* cB = (const char*)g.Bt + (size_t)cur.pn * tstep;
    S.a_ready(cur);
    E.prefetch(cur, wr, fr);
    PG8_STAGE(PG8_SB(0, 0), cB, voffB); PG8_STAGE(PG8_SA(0, 0), cA, voffA); PG8_STAGE(PG8_SB(0, 1), cB + hstep, voffB); PG8_STAGE(PG8_SA(0, 1), cA + hstep, voffA);
    if (wr == 1) PG8_BAR;
    PG8_WAIT_V(4); PG8_BAR;
    PG8_STAGE(PG8_SB(1, 0), cB + kstep, voffB); PG8_STAGE(PG8_SA(1, 0), cA + kstep, voffA); PG8_STAGE(PG8_SB(1, 1), cB + hstep + kstep, voffB);
    PG8_WAIT_V(6); PG8_BAR;
    PG8_STAMP();
    for (;;) {
        const bool has_next = S.next(ui + 1, nxt);
        const char* nA = has_next ? (const char*)g.A + (size_t)nxt.pm * tstep : cA; const char* nB = has_next ? (const char*)g.Bt + (size_t)nxt.pn * tstep : cB;
#pragma unroll 1
        for (int t = 0; t < nt; t += 2) {
            const bool last = (t == nt - 2);
            const char* a1 = cA + (size_t)(t + 1) * kstep;
            const char* a2 = last ? nA : cA + (size_t)(t + 2) * kstep; const char* b2 = last ? nB : cB + (size_t)(t + 2) * kstep;
            const char* a3 = a2 + kstep; const char* b3 = b2 + kstep;
            if (last && has_next) S.a_ready(nxt);
            PG8_LDB(B0, 0, 0); PG8_SCHED; PG8_LDA(At, 0, 0); PG8_STAGE(PG8_SA(1, 1), a1 + hstep, voffA);
            PG8_WAIT_L(8); PG8_BAR; PG8_WAIT_L(0); PG8_MMA(0, 0, At, B0); PG8_BAR; PG8_SCHED;
            PG8_LDB(B1, 0, 1); PG8_STAGE(PG8_SB(0, 0), b2, voffB);
            PG8_BAR; PG8_WAIT_L(0); PG8_MMA(0, 1, At, B1); PG8_BAR;
            PG8_LDA(At, 0, 1); PG8_STAGE(PG8_SA(0, 0), a2, voffA);
            PG8_BAR; PG8_WAIT_L(0); PG8_MMA(1, 0, At, B0); PG8_BAR; PG8_SCHED;
            PG8_STAGE(PG8_SB(0, 1), b2 + hstep, voffB);
            PG8_WAIT_V(6); PG8_BAR; PG8_MMA(1, 1, At, B1); PG8_BAR;
            PG8_LDB(B0, 1, 0); PG8_SCHED; PG8_LDA(At, 1, 0); PG8_STAGE(PG8_SA(0, 1), a2 + hstep, voffA);
            PG8_WAIT_L(8); PG8_BAR; PG8_WAIT_L(0); PG8_MMA(0, 0, At, B0); PG8_BAR; PG8_SCHED;
            PG8_LDB(B1, 1, 1); PG8_STAGE(PG8_SB(1, 0), b3, voffB);
            PG8_BAR; PG8_WAIT_L(0); PG8_MMA(0, 1, At, B1); PG8_BAR;
            PG8_LDA(At, 1, 1); PG8_STAGE(PG8_SA(1, 0), a3, voffA);
            PG8_BAR; PG8_WAIT_L(0); PG8_MMA(1, 0, At, B0); PG8_BAR; PG8_SCHED;
            PG8_STAGE(PG8_SB(1, 1), b3 + hstep, voffB);
            PG8_WAIT_V(6); PG8_BAR; PG8_MMA(1, 1, At, B1); PG8_BAR;
        }
        PG8_STAMP();
        if constexpr (!Epi::AFTER_DRAIN) { E(acc, cur, wr, wc, fr, fq); if (has_next) E.prefetch(nxt, wr, fr); S.done(cur); }
        PG8_STAMP();
        if (!has_next) break;
#pragma unroll
        for (int a = 0; a < 2; ++a)
#pragma unroll
            for (int b = 0; b < 2; ++b)
#pragma unroll
                for (int m = 0; m < 4; ++m)
#pragma unroll
                    for (int n = 0; n < 2; ++n) acc[a][b][m][n] = (f32x4){0.f, 0.f, 0.f, 0.f};
        cur = nxt; cA = nA; cB = nB; ++ui;
    }
    PG8_WAIT_V(0);
    if (wr == 0) PG8_BAR;
    PG8_BAR;
    if constexpr (Epi::AFTER_DRAIN) { E.fused(acc, cur, wr, wc, fr, fq, lds, wid, lane); S.done(cur); }
    PG8_STAMP();
    if (STAMP && wid == 0) { stamps[lane] = lane < nts ? (((unsigned long long)(unsigned)ts_hi << 32) | (unsigned)ts_lo) : 0ull;
        if (lane == 62) stamps[62] = rt_entry; if (lane == 63) stamps[63] = (unsigned long long)wall_clock64(); }
#undef PG8_STAMP
#undef PG8_SA
#undef PG8_SB
#undef PG8_STAGE
#undef PG8_LDA
#undef PG8_LDB
#undef PG8_MMA
#undef PG8_WAIT_V
#undef PG8_WAIT_L
#undef PG8_BAR
#undef PG8_SCHED
}
}
using namespace pg8;
typedef short bf16x4 __attribute__((ext_vector_type(4)));
typedef float f32x16 __attribute__((ext_vector_type(16)));
typedef unsigned u32x2 __attribute__((ext_vector_type(2)));
typedef float f32x2_t __attribute__((ext_vector_type(2)));

constexpr int DM = 1024, NBATCH = 16, SEQ = 4096, LP = 4224, MROWS = NBATCH * LP, DINP = 3072, DFF = 2816;
constexpr int NCH32 = LP / 32;
constexpr int S5ROWS = 2304;
constexpr int XCD_BAR_WORDS_C = 3456;
constexpr float RMS_EPS = 1e-6f, LOG2E = 1.4426950408889634f;

constexpr size_t SZ_HB = (size_t)MROWS * 1024 * 2;
constexpr size_t OFF_HB = 0;
constexpr size_t SZ_URE = (size_t)16 * S5ROWS * 512 * 2;
constexpr size_t SZ_XEND = (size_t)16 * S5ROWS * 128 * 4;
constexpr size_t SZ_XST = (size_t)16 * S5ROWS * 256 * 2;
constexpr size_t OFF_PROJ = OFF_HB + SZ_HB;
constexpr size_t SZ_PROJ = (size_t)MROWS * DINP * 2;
constexpr size_t OFF_ACT = OFF_PROJ;
constexpr size_t SZ_T = (size_t)MROWS * 384 * 2;
constexpr size_t OFF_VST = OFF_PROJ + SZ_PROJ, OFF_VRT = OFF_VST + SZ_T, OFF_KRT = OFF_VRT + SZ_T;
constexpr size_t OFF_MIX = OFF_KRT + SZ_T;
constexpr size_t OFF_W = OFF_MIX + SZ_HB;
constexpr size_t WL_IN = 0, WL_OUT = (size_t)DINP * 1024 * 2, WL_GU = WL_OUT + (size_t)1024 * 1024 * 2, WL_DN = WL_GU + (size_t)5632 * 1024 * 2,
                 WL_GLU = WL_DN + (size_t)1024 * DFF * 2, SZ_WL = WL_GLU + (size_t)256 * 256 * 2;
constexpr size_t OFF_S5M = OFF_W + 2 * SZ_WL;
constexpr size_t S5M_BT1 = 0, S5M_E = (size_t)16 * 768 * 512 * 2, SZ_S5M = S5M_E + (size_t)16 * 512 * 256 * 2;
constexpr size_t OFF_SSQ = OFF_S5M + 2 * SZ_S5M;
constexpr size_t OFF_SSQD = OFF_SSQ + (size_t)MROWS * 4;
constexpr size_t OFF_HSS = OFF_SSQ + (size_t)MROWS * 2 * 4;
constexpr size_t OFF_HMETA = OFF_SSQ + (size_t)MROWS * 16 * 4;
constexpr size_t OFF_HINV = OFF_HMETA;
constexpr size_t OFF_ROT = OFF_HMETA + (size_t)NBATCH * 128 * 1024 * 4;
constexpr size_t OFF_S5P = OFF_ROT + (size_t)LP * 32 * 2 * 4;
constexpr size_t S5P_BB = 0, S5P_PW = (size_t)16 * 64 * 16 * 2 * 4, SZ_S5P = S5P_PW + (size_t)16 * 64 * 33 * 2 * 4;
constexpr size_t OFF_CTR = OFF_S5P + 2 * SZ_S5P;
constexpr size_t OFF_BAR = OFF_CTR + 256;
constexpr size_t OFF_URE = OFF_BAR + 16384;
constexpr size_t OFF_YLOC = OFF_URE + SZ_URE;
constexpr size_t OFF_XEND = OFF_YLOC + SZ_URE;
constexpr size_t OFF_XST = OFF_XEND + SZ_XEND;
constexpr size_t OFF_YBUF = OFF_VST;
constexpr size_t WS_NEED = OFF_XST + SZ_XST;
static_assert(WS_NEED <= (size_t)1024 * 1024 * 1024, "workspace too large");
static_assert((size_t)MROWS * 256 * 2 <= SZ_T, "ybuf must fit in the VsT region");

constexpr int NREAL = NBATCH * SEQ;
__device__ __forceinline__ int row_of(int b, int i) { return i >= 128 ? b * SEQ + (i - 128) : NREAL + b * 128 + i; }
__device__ __forceinline__ void bi_of(int row, int& b, int& i) { if (row < NREAL) { b = row >> 12; i = (row & (SEQ - 1)) + 128; } else { b = (row - NREAL) >> 7; i = row & 127; } }

struct Params {
    const float *x, *meta, *norm1_g, *w_in, *sb_q_g, *sb_k_g, *ret_q_g, *ret_k_g, *ret_out_g, *lam_re, *lam_im, *log_dt, *b_re, *b_im, *c_re, *c_im, *s5_d, *w_glu,
        *w_out, *norm2_g, *w_gate, *w_up, *w_down;
    float* out;
    unsigned char* ws;
};

#define GAS __attribute__((address_space(1)))
__device__ __forceinline__ void gst16(void* q, u32x4 v) { *(GAS u32x4*)q = v; }
__device__ __forceinline__ void gst16f(void* q, f32x4 v) { *(GAS f32x4*)q = v; }
__device__ __forceinline__ u32x4 gld16(const void* q) { return *(const GAS u32x4*)q; }
__device__ __forceinline__ void gst16_nt(void* q, u32x4 v) { __builtin_nontemporal_store(v, (GAS u32x4*)q); }
__device__ __forceinline__ void gst16f_nt(void* q, f32x4 v) { __builtin_nontemporal_store(v, (GAS f32x4*)q); }
__device__ __forceinline__ void gst8(void* q, u32x2 v) { *(GAS u32x2*)q = v; }
__device__ __forceinline__ u32x2 gld8(const void* q) { return *(const GAS u32x2*)q; }
__device__ __forceinline__ f32x4 gld16f(const void* q) { return *(const GAS f32x4*)q; }
__device__ __forceinline__ float gld4f(const void* q) { return *(const GAS float*)q; }
__device__ __forceinline__ void gatomic_addf(float* q, float v) { __hip_atomic_fetch_add((GAS float*)q, v, __ATOMIC_RELAXED, __HIP_MEMORY_SCOPE_AGENT); }
__device__ __forceinline__ float bf2f(bf16_t v) { return __uint_as_float(((unsigned)v) << 16); }
__device__ __forceinline__ bf16_t f2bf(float f) { unsigned u = __float_as_uint(f); u += 0x7FFFu + ((u >> 16) & 1u); return (bf16_t)(u >> 16); }
__device__ __forceinline__ float lo_bf(unsigned w) { return __uint_as_float(w << 16); }
__device__ __forceinline__ float hi_bf(unsigned w) { return __uint_as_float(w & 0xffff0000u); }
__device__ __forceinline__ u32x4 pack8(const float* f) { u32x4 w; w.x = cvt_pk_bf16(f[0], f[1]); w.y = cvt_pk_bf16(f[2], f[3]); w.z = cvt_pk_bf16(f[4], f[5]); w.w = cvt_pk_bf16(f[6], f[7]); return w; }
__device__ __forceinline__ void unpack8(u32x4 w, float* f) { f[0] = lo_bf(w.x); f[1] = hi_bf(w.x); f[2] = lo_bf(w.y); f[3] = hi_bf(w.y); f[4] = lo_bf(w.z); f[5] = hi_bf(w.z); f[6] = lo_bf(w.w); f[7] = hi_bf(w.w); }
__device__ __forceinline__ float log_gamma_h(int h) { const float x = __builtin_amdgcn_exp2f(-5.0f - (float)h); return -x * (1.0f + x * (0.5f + x * (0.33333334f + x * (0.25f + x * 0.2f)))); }
__device__ __forceinline__ float sigmoidf_(float v) { return __builtin_amdgcn_rcpf(1.0f + __builtin_amdgcn_exp2f(-LOG2E * v)); }
__device__ __forceinline__ float gelu_tanh(float y) { const float t = (1.5957691216057308f * LOG2E) * (y + 0.044715f * y * y * y); return y * __builtin_amdgcn_rcpf(1.0f + __builtin_amdgcn_exp2f(-t)); }
#define MFMA32(a, b, c) __builtin_amdgcn_mfma_f32_32x32x16_bf16((a), (b), (c), 0, 0, 0)

struct BatchedOrder {
    int nPm, nPn, nwg, G, c;
    __device__ void init(int nG, int nPm_, int nPn_, int G_, int c_) { nPm = nPm_; nPn = nPn_; nwg = nG * nPm_ * nPn_; G = G_; c = c_; }
    __device__ bool next(int i, Unit& u) const {
        const long L = (long)i * G + c; if (L >= nwg) return false;
        const int per = nPm * nPn, g = (int)L / per, rem = (int)L % per; u.pm = g * nPm + rem / nPn; u.pn = g * nPn + rem % nPn; return true;
    }
    __device__ __forceinline__ void a_ready(const Unit&) const {}
    __device__ __forceinline__ void done(const Unit&) const {}
};

__device__ __forceinline__ float row_rs(const float* ssq, int row) { return rsqrtf(gld4f(ssq + row) * (1.0f / 1024.0f) + RMS_EPS); }

struct EpiProj {
    static constexpr bool PERM = true, AFTER_DRAIN = false;
    bf16_t* O; const float* ssq; bf16_t* ure; bf16_t* vst; bf16_t* vrt; float* hss; const float* qg; const float* kg; mutable float rsn[8];
    __device__ __forceinline__ void prefetch(const Unit& u, int wr, int fr) const { const int row0 = u.pm * BM + wr * 64 + fr;
#pragma unroll
        for (int q = 0; q < 8; ++q) rsn[q] = gld4f(ssq + row0 + (q >> 2) * HALF + (q & 3) * 16); }
    __device__ __forceinline__ void operator()(const f32x4 (&acc)[2][2][4][2], const Unit& u, int wr, int wc, int fr, int fq) const {
        const int row0 = u.pm * BM + wr * 64 + fr, col0 = u.pn * BM + wc * 32 + 8 * fq; float rsv[8];
#pragma unroll
        for (int q = 0; q < 8; ++q) rsv[q] = rsqrtf(rsn[q] * (1.0f / 1024.0f) + RMS_EPS);
        float tq[2][8];
#pragma unroll
        for (int bj = 0; bj < 2; ++bj) { const int cb = u.pn * BM + bj * HALF, d0 = (col0 + bj * HALF) & 63;
#pragma unroll
            for (int e = 0; e < 8; ++e) { float t = 1.0f; if (cb < 384) { const float gi = __builtin_amdgcn_rcpf(gld4f(qg + d0 + e) * gld4f(kg + d0 + e) * (0.125f * LOG2E)); t = gi * gi; } tq[bj][e] = t; } }
#pragma unroll
        for (int ai = 0; ai < 2; ++ai)
#pragma unroll
            for (int m = 0; m < 4; ++m) { const int row = row0 + ai * HALF + m * 16; const float rs = rsv[ai * 4 + m]; bf16_t* rowp = O + (size_t)row * DINP + col0;
#pragma unroll
                for (int bj = 0; bj < 2; ++bj) { const int col = col0 + bj * HALF, cb = u.pn * BM + bj * HALF; if (cb >= 2944) continue;
                    const f32x4 v0 = acc[ai][bj][m][0] * rs, v1 = acc[ai][bj][m][1] * rs;
                    u32x4 w; w.x = cvt_pk_bf16(v0[0], v0[1]); w.y = cvt_pk_bf16(v0[2], v0[3]); w.z = cvt_pk_bf16(v1[0], v1[1]); w.w = cvt_pk_bf16(v1[2], v1[3]);
                    const bool isv = (cb >= 768 && cb < 1152) || (cb >= 1920 && cb < 2304);
                    if (cb >= 2688) { int b, i; bi_of(row, b, i); const int c0 = col - 2688, g = c0 >> 4;
                        gst16(ure + ((size_t)g * S5ROWS + b * NCH32 + (i >> 5)) * 512 + (i & 31) * 16 + (c0 & 15), w); }
                    else if (isv) { int b, i; bi_of(row, b, i); const int c0 = col - (cb < 1152 ? 768 : 1920);
                        GAS bf16_t* dst = (GAS bf16_t*)(cb < 1152 ? vst : vrt) + ((size_t)(b * 6 + (c0 >> 6)) * 64 + (c0 & 63)) * LP + i;
                        dst[0] = (bf16_t)w.x; dst[LP] = (bf16_t)(w.x >> 16); dst[2 * LP] = (bf16_t)w.y; dst[3 * LP] = (bf16_t)(w.y >> 16);
                        dst[4 * LP] = (bf16_t)w.z; dst[5 * LP] = (bf16_t)(w.z >> 16); dst[6 * LP] = (bf16_t)w.w; dst[7 * LP] = (bf16_t)(w.w >> 16); }
                    else { gst16(rowp + bj * HALF, w);
                        if (cb < 768) {
                            float part = v0[0] * v0[0] * tq[bj][0] + v0[1] * v0[1] * tq[bj][1] + v0[2] * v0[2] * tq[bj][2] + v0[3] * v0[3] * tq[bj][3] + v1[0] * v1[0] * tq[bj][4] + v1[1] * v1[1] * tq[bj][5] + v1[2] * v1[2] * tq[bj][6] + v1[3] * v1[3] * tq[bj][7];
                            part += __shfl_xor(part, 16); part += __shfl_xor(part, 32);
                            if (fq == 0) gatomic_addf(hss + (size_t)row * 12 + (col >> 6), part); } } } }
    }
};

struct EpiAct {
    static constexpr bool PERM = true, AFTER_DRAIN = false;
    bf16_t* O; const float* ssq; mutable float rsn[8];
    __device__ __forceinline__ void prefetch(const Unit& u, int wr, int fr) const { const int row0 = u.pm * BM + wr * 64 + fr;
#pragma unroll
        for (int q = 0; q < 8; ++q) rsn[q] = gld4f(ssq + row0 + (q >> 2) * HALF + (q & 3) * 16); }
    __device__ __forceinline__ void operator()(const f32x4 (&acc)[2][2][4][2], const Unit& u, int wr, int wc, int fr, int fq) const {
        const int row0 = u.pm * BM + wr * 64 + fr, col0 = u.pn * HALF + wc * 32 + 8 * fq; float rsv[8];
#pragma unroll
        for (int q = 0; q < 8; ++q) rsv[q] = rsqrtf(rsn[q] * (1.0f / 1024.0f) + RMS_EPS);
#pragma unroll
        for (int ai = 0; ai < 2; ++ai)
#pragma unroll
            for (int m = 0; m < 4; ++m) { const int row = row0 + ai * HALF + m * 16; const float rs = rsv[ai * 4 + m]; float o[8];
#pragma unroll
                for (int n = 0; n < 2; ++n)
#pragma unroll
                    for (int j = 0; j < 4; ++j) { const float g = acc[ai][0][m][n][j] * rs, up = acc[ai][1][m][n][j] * rs; o[n * 4 + j] = g * sigmoidf_(g) * up; }
                gst16_nt(O + (size_t)row * DFF + col0, pack8(o)); }
    }
};

struct EpiNop { static constexpr bool PERM = true, AFTER_DRAIN = false; float* sink;
    __device__ __forceinline__ void prefetch(const Unit&, int, int) const {}
    __device__ __forceinline__ void operator()(const f32x4 (&acc)[2][2][4][2], const Unit& u, int wr, int wc, int fr, int fq) const { f32x4 t = (f32x4){0.f, 0.f, 0.f, 0.f};
#pragma unroll
        for (int a = 0; a < 2; ++a)
#pragma unroll
            for (int b = 0; b < 2; ++b)
#pragma unroll
                for (int m = 0; m < 4; ++m) { t += acc[a][b][m][0]; t += acc[a][b][m][1]; }
        if (t.x + t.y + t.z + t.w == 123.456f) sink[0] = 1.0f; } };

struct EpiRes {
    static constexpr bool PERM = true, AFTER_DRAIN = false;
    bf16_t* hb; float* ssq; float* out; int last;
    __device__ __forceinline__ void prefetch(const Unit&, int, int) const {}
    __device__ __forceinline__ void operator()(const f32x4 (&acc)[2][2][4][2], const Unit& u, int wr, int wc, int fr, int fq) const {
        const int row0 = u.pm * BM + wr * 64 + fr, col0 = u.pn * BM + wc * 32 + 8 * fq;
#pragma unroll
        for (int ai = 0; ai < 2; ++ai) {
            u32x4 hv[4][2];
#pragma unroll
            for (int m = 0; m < 4; ++m)
#pragma unroll
                for (int bj = 0; bj < 2; ++bj) hv[m][bj] = gld16(hb + (size_t)(row0 + ai * HALF + m * 16) * 1024 + col0 + bj * HALF);
            __builtin_amdgcn_sched_barrier(0);
#pragma unroll
            for (int m = 0; m < 4; ++m) { const int row = row0 + ai * HALF + m * 16; int b, i; bi_of(row, b, i);
                bf16_t* hp = hb + (size_t)row * 1024 + col0; const float valid = i >= 112 ? 1.0f : 0.0f; float part = 0.f;
#pragma unroll
                for (int bj = 0; bj < 2; ++bj) { float h[8]; unpack8(hv[m][bj], h);
                    const f32x4 v0 = ((f32x4){h[0], h[1], h[2], h[3]} + acc[ai][bj][m][0]) * valid, v1 = ((f32x4){h[4], h[5], h[6], h[7]} + acc[ai][bj][m][1]) * valid;
                    if (!last) { u32x4 w; w.x = cvt_pk_bf16(v0[0], v0[1]); w.y = cvt_pk_bf16(v0[2], v0[3]); w.z = cvt_pk_bf16(v1[0], v1[1]); w.w = cvt_pk_bf16(v1[2], v1[3]);
                        gst16(hp + bj * HALF, w);
                        part += v0[0] * v0[0] + v0[1] * v0[1] + v0[2] * v0[2] + v0[3] * v0[3] + v1[0] * v1[0] + v1[1] * v1[1] + v1[2] * v1[2] + v1[3] * v1[3]; }
                    else if (i >= 128) { float* d = out + ((size_t)b * SEQ + (i - 128)) * 1024 + col0 + bj * HALF; gst16f_nt(d, v0); gst16f_nt(d + 4, v1); } }
                if (!last) { part += __shfl_xor(part, 16); part += __shfl_xor(part, 32); if (fq == 0) gatomic_addf(ssq + row, part); } }
            __builtin_amdgcn_sched_barrier(0); }
    }
};

struct EpiS5a {
    static constexpr bool PERM = true, AFTER_DRAIN = false;
    bf16_t* yloc; float* xend;
    __device__ __forceinline__ void prefetch(const Unit&, int, int) const {}
    __device__ __forceinline__ void operator()(const f32x4 (&acc)[2][2][4][2], const Unit& u, int wr, int wc, int fr, int fq) const {
        const int g = u.pm / 9, prow = u.pm - g * 9, pcol = u.pn - g * 3;
        const int rr0 = prow * BM + wr * 64 + fr, cc0 = wc * 32 + 8 * fq;
#pragma unroll
        for (int ai = 0; ai < 2; ++ai)
#pragma unroll
            for (int m = 0; m < 4; ++m) { const int rr = rr0 + ai * HALF + m * 16; const size_t grow = (size_t)g * S5ROWS + rr;
                if (pcol < 2) {
#pragma unroll
                    for (int bj = 0; bj < 2; ++bj) { const f32x4 v0 = acc[ai][bj][m][0], v1 = acc[ai][bj][m][1];
                        u32x4 w; w.x = cvt_pk_bf16(v0[0], v0[1]); w.y = cvt_pk_bf16(v0[2], v0[3]); w.z = cvt_pk_bf16(v1[0], v1[1]); w.w = cvt_pk_bf16(v1[2], v1[3]);
                        gst16(yloc + grow * 512 + pcol * 256 + bj * HALF + cc0, w); }
                } else { float* xp = xend + grow * 128 + cc0; gst16f(xp, acc[ai][0][m][0]); gst16f(xp + 4, acc[ai][0][m][1]); } }
    }
};

struct EpiS5b {
    static constexpr bool PERM = true, AFTER_DRAIN = false;
    const bf16_t* yloc; const bf16_t* ure; const float* dskip; bf16_t* ybuf;
    __device__ __forceinline__ void prefetch(const Unit&, int, int) const {}
    __device__ __forceinline__ void operator()(const f32x4 (&acc)[2][2][4][2], const Unit& u, int wr, int wc, int fr, int fq) const {
        const int g = u.pm / 9, prow = u.pm - g * 9, pcol = u.pn - g * 2;
        const int rr0 = prow * BM + wr * 64 + fr, cc0 = pcol * 256 + wc * 32 + 8 * fq, c = cc0 & 15;
        const f32x4 d0 = gld16f(dskip + 16 * g + c), d1 = gld16f(dskip + 16 * g + c + 4);
#pragma unroll
        for (int ai = 0; ai < 2; ++ai)
#pragma unroll
            for (int mp = 0; mp < 2; ++mp) {
                u32x4 ylv[2][2], uuv[2][2];
#pragma unroll
                for (int mm = 0; mm < 2; ++mm)
#pragma unroll
                    for (int bj = 0; bj < 2; ++bj) { const int rr = rr0 + ai * HALF + (2 * mp + mm) * 16; const size_t grow = (size_t)g * S5ROWS + (rr < NBATCH * NCH32 ? rr : 0);
                        ylv[mm][bj] = gld16(yloc + grow * 512 + cc0 + bj * HALF); uuv[mm][bj] = gld16(ure + grow * 512 + cc0 + bj * HALF); }
                __builtin_amdgcn_sched_barrier(0);
#pragma unroll
                for (int mm = 0; mm < 2; ++mm) { const int m = 2 * mp + mm, rr = rr0 + ai * HALF + m * 16; if (rr >= NBATCH * NCH32) continue;
                    const int b = rr / NCH32, n = rr - b * NCH32;
#pragma unroll
                    for (int bj = 0; bj < 2; ++bj) { const int cc = cc0 + bj * HALF, t = cc >> 4; const size_t trow = (size_t)row_of(b, n * 32 + t);
                        float yl[8], uu[8], o[8]; unpack8(ylv[mm][bj], yl); unpack8(uuv[mm][bj], uu);
#pragma unroll
                        for (int j = 0; j < 4; ++j) { o[j] = gelu_tanh(acc[ai][bj][m][0][j] + yl[j] + d0[j] * uu[j]); o[4 + j] = gelu_tanh(acc[ai][bj][m][1][j] + yl[4 + j] + d1[j] * uu[4 + j]); }
                        gst16(ybuf + trow * 256 + 16 * g + c, pack8(o)); } }
                __builtin_amdgcn_sched_barrier(0); }
    }
};

struct EpiGlu {
    static constexpr bool PERM = true, AFTER_DRAIN = false;
    const bf16_t* ybuf; bf16_t* mix;
    __device__ __forceinline__ void prefetch(const Unit&, int, int) const {}
    __device__ __forceinline__ void operator()(const f32x4 (&acc)[2][2][4][2], const Unit& u, int wr, int wc, int fr, int fq) const {
        const int row0 = u.pm * BM + wr * 64 + fr, col0 = wc * 32 + 8 * fq;
#pragma unroll
        for (int ai = 0; ai < 2; ++ai) {
            u32x4 yv[4][2];
#pragma unroll
            for (int m = 0; m < 4; ++m)
#pragma unroll
                for (int bj = 0; bj < 2; ++bj) yv[m][bj] = gld16(ybuf + (size_t)(row0 + ai * HALF + m * 16) * 256 + col0 + bj * HALF);
            __builtin_amdgcn_sched_barrier(0);
#pragma unroll
            for (int m = 0; m < 4; ++m) { const size_t row = row0 + ai * HALF + m * 16;
#pragma unroll
                for (int bj = 0; bj < 2; ++bj) { const int col = col0 + bj * HALF; float y[8], o[8]; unpack8(yv[m][bj], y);
#pragma unroll
                    for (int j = 0; j < 4; ++j) { o[j] = y[j] * sigmoidf_(acc[ai][bj][m][0][j]); o[4 + j] = y[4 + j] * sigmoidf_(acc[ai][bj][m][1][j]); }
                    gst16(mix + row * 1024 + 768 + col, pack8(o)); } }
            __builtin_amdgcn_sched_barrier(0); }
    }
};

#define XB_TMO      128
#define XB_XCNT(j)  (256  + 64 * (j))
#define XB_XSUB(j)  (1280 + 64 * (j))
#define XB_XGEN(j)  (2304 + 64 * (j))
#define XB_TOP      3328
#define XB_TOPGEN   3392
#define XCD_BAR_WORDS 3456
#define XB_SPIN_CAP (1u << 18)
#define LAS __attribute__((address_space(3)))

__device__ __forceinline__ unsigned xb_ld(unsigned* p)              { return __hip_atomic_load(p, __ATOMIC_RELAXED, __HIP_MEMORY_SCOPE_AGENT); }
__device__ __forceinline__ unsigned xb_add(unsigned* p, unsigned v) { return __hip_atomic_fetch_add(p, v, __ATOMIC_RELAXED, __HIP_MEMORY_SCOPE_AGENT); }
__device__ __forceinline__ unsigned xb_xcc_id() { return (unsigned)__builtin_amdgcn_s_getreg((3 << 11) | 20) & 0xFu; }
#define XB_SPIN(cond, bar) do { unsigned _sp = 0; while (cond) { __builtin_amdgcn_s_sleep(1); \
    if ((++_sp & 255u) == 0u) { if (xb_ld(&(bar)[XB_TMO])) break; if (_sp > XB_SPIN_CAP) { atomicAdd(&(bar)[XB_TMO], 1u); break; } } } } while (0)
struct XcdBarrier {
    unsigned* bar; unsigned x;
    volatile LAS unsigned* st;
};

__device__ __forceinline__ XcdBarrier xcd_barrier_post(unsigned* bar, volatile LAS unsigned* st) {
    XcdBarrier b; b.bar = bar; b.x = xb_xcc_id(); b.st = st;
    if (threadIdx.x == 0) (void)xb_add(&bar[XB_XCNT(b.x)], 1u);
    return b;
}
__device__ __forceinline__ void xcd_barrier_complete(unsigned* bar, unsigned x, unsigned& nloc, unsigned& nx) {
    const unsigned G = gridDim.x * gridDim.y * gridDim.z;
    unsigned sum, cnt, mine, sp = 0u;
    for (;;) {
        sum = 0u; cnt = 0u; mine = 0u;
#pragma unroll
        for (unsigned j = 0; j < 16; ++j) { const unsigned c = xb_ld(&bar[XB_XCNT(j)]); sum += c; cnt += (c > 0u) ? 1u : 0u; mine = (j == x) ? c : mine; }
        if (sum == G) break;
        __builtin_amdgcn_s_sleep(1);
        if ((++sp & 255u) == 0u) { if (xb_ld(&bar[XB_TMO])) break; if (sp > XB_SPIN_CAP) { atomicAdd(&bar[XB_TMO], 1u); break; } }
    }
    nloc = mine > 0u ? mine : 1u; nx = cnt > 0u ? cnt : 1u;
}

__device__ __forceinline__ void xcd_barrier(const XcdBarrier& b) {
    asm volatile("s_waitcnt vmcnt(0)" ::: "memory");
    __syncthreads();
    if (threadIdx.x == 0) {
        unsigned* bar = b.bar;
        __builtin_amdgcn_s_waitcnt(0);
        unsigned nloc = b.st[0], nx = b.st[1];
        if (nloc == 0u) { xcd_barrier_complete(bar, b.x, nloc, nx); b.st[0] = nloc; b.st[1] = nx; }
        const unsigned old = xb_add(&bar[XB_XSUB(b.x)], 1u);
        const unsigned gen = old / nloc;
        if (old + 1u == (gen + 1u) * nloc) {
            __builtin_amdgcn_fence(__ATOMIC_RELEASE, "agent");
            asm volatile("s_waitcnt vmcnt(0)" ::: "memory");
            const unsigned og = xb_add(&bar[XB_TOP], 1u);
            const unsigned tg = og / nx;
            if (og + 1u == (tg + 1u) * nx) xb_add(&bar[XB_TOPGEN], 1u);
            else XB_SPIN(xb_ld(&bar[XB_TOPGEN]) == tg, bar);
            __builtin_amdgcn_fence(__ATOMIC_ACQUIRE, "agent");
            xb_add(&bar[XB_XGEN(b.x)], 1u);
            asm volatile("s_waitcnt vmcnt(0)" ::: "memory");
        } else {
            XB_SPIN(xb_ld(&bar[XB_XGEN(b.x)]) == gen, bar);
            __builtin_amdgcn_fence(__ATOMIC_ACQUIRE, "agent");
            asm volatile("s_waitcnt vmcnt(0)" ::: "memory");
        }
    }
    __syncthreads();
}

#ifndef STAG_ALL_US
#define STAG_ALL_US 0
#endif
__device__ __forceinline__ void phase_stagger(int nwg, int G, int c, int unit_us) {
    const int nmax = (nwg + G - 1) / G, mine = nwg > c ? (nwg - c + G - 1) / G : 0;
    const unsigned h = ((unsigned)c * 2654435761u) >> 24;
    int us = (mine < nmax) ? (int)((unsigned)unit_us * h) >> 8 : (int)((unsigned)STAG_ALL_US * h) >> 8;
    if (us > 0) { const unsigned long long t0 = __builtin_amdgcn_s_memrealtime(), ticks = (unsigned long long)us * 100ull;
        while (__builtin_amdgcn_s_memrealtime() - t0 < ticks) __builtin_amdgcn_s_sleep(16); }
}

__device__ __forceinline__ void wtile(const float* W, int N, int k0, int n0, const float* gk, bf16_t* Wt, int ldk, int mode, int lane, float cs = 1.0f) {
    const int n = n0 + lane, drow = mode == 0 ? n : ((n >> 7) * 256 + (mode == 2 ? 128 : 0) + (n & 127));
    bf16_t* dst = Wt + (size_t)drow * ldk + k0; const float* src = W + (size_t)k0 * N + n;
#pragma unroll
    for (int hf = 0; hf < 2; ++hf) { float f[32];
#pragma unroll
        for (int kk = 0; kk < 32; ++kk) f[kk] = src[(size_t)(32 * hf + kk) * N];
        if (gk) {
#pragma unroll
            for (int kk = 0; kk < 32; ++kk) f[kk] *= gk[k0 + 32 * hf + kk] * cs; }
#pragma unroll
        for (int q = 0; q < 4; ++q) *(u32x4*)(dst + 32 * hf + 8 * q) = pack8(f + 8 * q); }
}

__device__ __forceinline__ void phase_prep1(const Params& p, unsigned char* shm) {
    const int tid = tid_fresh(), nb = gridDim.x, bid = blockIdx.x;
    if (bid == 0 && tid < 64) ((unsigned*)(p.ws + OFF_CTR))[tid] = 0u;
    for (size_t e = (size_t)bid * 512 + tid; e < (size_t)MROWS * 12; e += (size_t)nb * 512) ((float*)(p.ws + OFF_HSS))[e] = 0.f;
    constexpr int T_IN = 16 * 46, T_OUT = 16 * 16, T_G = 16 * 44, T_D = 44 * 16, T_GLU = 16, T_L = T_IN + T_OUT + 2 * T_G + T_D + T_GLU;
    const int wvp = tid >> 6, lanep = tid & 63;
#pragma unroll 1
    for (int it = bid * 8 + wvp; it < 2 * T_L; it += nb * 8) {
        const int l = it / T_L; int r = it - l * T_L; unsigned char* wl = p.ws + OFF_W + (size_t)l * SZ_WL;
        if (r < T_IN) { const int n0 = (r % 46) * 64; const float cs = n0 < 384 ? p.sb_q_g[l * 64 + lanep] * p.sb_k_g[l * 64 + lanep] * (0.125f * LOG2E) : 1.0f;
            wtile(p.w_in + (size_t)l * 1024 * 2944, 2944, (r / 46) * 64, n0, p.norm1_g + l * 1024, (bf16_t*)(wl + WL_IN), 1024, 0, lanep, cs); continue; } r -= T_IN;
        if (r < T_OUT) { wtile(p.w_out + (size_t)l * 1024 * 1024, 1024, (r / 16) * 64, (r % 16) * 64, nullptr, (bf16_t*)(wl + WL_OUT), 1024, 0, lanep); continue; } r -= T_OUT;
        if (r < T_G) { wtile(p.w_gate + (size_t)l * 1024 * DFF, DFF, (r / 44) * 64, (r % 44) * 64, p.norm2_g + l * 1024, (bf16_t*)(wl + WL_GU), 1024, 1, lanep); continue; } r -= T_G;
        if (r < T_G) { wtile(p.w_up + (size_t)l * 1024 * DFF, DFF, (r / 44) * 64, (r % 44) * 64, p.norm2_g + l * 1024, (bf16_t*)(wl + WL_GU), 1024, 2, lanep); continue; } r -= T_G;
        if (r < T_D) { wtile(p.w_down + (size_t)l * DFF * 1024, 1024, (r / 16) * 64, (r % 16) * 64, nullptr, (bf16_t*)(wl + WL_DN), DFF, 0, lanep); continue; } r -= T_D;
        wtile(p.w_glu + (size_t)l * 256 * 256, 256, (r / 4) * 64, (r % 4) * 64, nullptr, (bf16_t*)(wl + WL_GLU), 256, 0, lanep);
    }
    const size_t gtid = (size_t)bid * 512 + tid, gthreads = (size_t)nb * 512;
    for (size_t e = gtid; e < (size_t)2 * 128 * 128; e += gthreads) { const int l = (int)(e / (128 * 128)), q = (int)(e % (128 * 128));
        *(u32x4*)(p.ws + OFF_W + (size_t)l * SZ_WL + WL_IN + ((size_t)2944 * 1024 + (size_t)q * 8) * 2) = (u32x4){0u, 0u, 0u, 0u}; }
    { bf16_t* hb = (bf16_t*)(p.ws + OFF_HB); float* ssq = (float*)(p.ws + OFF_SSQ);
      const int wv = tid >> 6, lane = tid & 63;
      auto srcp = [&](int row) -> const float* { int b, i; bi_of(row, b, i); return i < 112 ? nullptr : (i < 128 ? p.meta + (size_t)(i - 112) * 1024 : p.x + ((size_t)b * SEQ + (i - 128)) * 1024); };
      f32x4 cur[4], nxt[4]; int row = bid * 8 + wv;
      { const float* src = row < MROWS ? srcp(row) : nullptr;
#pragma unroll
        for (int q = 0; q < 4; ++q) cur[q] = src ? *(const GAS f32x4*)(src + q * 256 + lane * 4) : (f32x4){0.f, 0.f, 0.f, 0.f}; }
#pragma unroll 1
      for (; row < MROWS; row += nb * 8) {
          const int rn = row + nb * 8; const float* srcn = rn < MROWS ? srcp(rn) : nullptr;
#pragma unroll
          for (int q = 0; q < 4; ++q) nxt[q] = srcn ? *(const GAS f32x4*)(srcn + q * 256 + lane * 4) : (f32x4){0.f, 0.f, 0.f, 0.f};
          float part = 0.f;
#pragma unroll
          for (int q = 0; q < 4; ++q) { const int c = q * 256 + lane * 4; const f32x4 v = cur[q];
              part += v.x * v.x + v.y * v.y + v.z * v.z + v.w * v.w;
              u32x2 w; w.x = cvt_pk_bf16(v.x, v.y); w.y = cvt_pk_bf16(v.z, v.w); gst8(hb + (size_t)row * 1024 + c, w); }
#pragma unroll
          for (int o = 32; o >= 1; o >>= 1) part += __shfl_xor(part, o);
          if (lane == 0) ssq[row] = part;
#pragma unroll
          for (int q = 0; q < 4; ++q) cur[q] = nxt[q]; } }
    { float* rot = (float*)(p.ws + OFF_ROT);
      for (size_t e = gtid; e < (size_t)LP * 32; e += gthreads) { const int i = (int)(e >> 5), f = (int)(e & 31);
          const float inv = powf(10000.0f, -(float)f / 32.0f), ang = (float)(i - 112) * inv; rot[2 * e] = cosf(ang); rot[2 * e + 1] = sinf(ang); } }
    for (size_t e = gtid; e < (size_t)2 * 16 * 64; e += gthreads) { const int l = (int)(e >> 10), gp = (int)(e & 1023), g = gp >> 6;
        const float lr = p.lam_re[l * 1024 + gp], li = p.lam_im[l * 1024 + gp], dt = expf(p.log_dt[l * 16 + g]);
        const float mag = expf(lr * dt), ar = mag * cosf(li * dt), ai = mag * sinf(li * dt), den = lr * lr + li * li;
        const float fr = ((ar - 1.0f) * lr + ai * li) / den, fi = (ai * lr - (ar - 1.0f) * li) / den;
        float* bb = (float*)(p.ws + OFF_S5P + (size_t)l * SZ_S5P + S5P_BB) + (size_t)gp * 32;
        for (int c = 0; c < 16; ++c) { const float br = p.b_re[((size_t)l * 1024 + gp) * 16 + c], bi = p.b_im[((size_t)l * 1024 + gp) * 16 + c]; bb[2 * c] = fr * br - fi * bi; bb[2 * c + 1] = fr * bi + fi * br; } }
    for (size_t e = gtid; e < (size_t)2 * 16 * 64 * 33; e += gthreads) { const int d = (int)(e % 33), lgp = (int)(e / 33), l = lgp >> 10, gp = lgp & 1023, g = gp >> 6;
        const float lr = p.lam_re[l * 1024 + gp], li = p.lam_im[l * 1024 + gp], dt = expf(p.log_dt[l * 16 + g]);
        float* pw = (float*)(p.ws + OFF_S5P + (size_t)l * SZ_S5P + S5P_PW) + (size_t)gp * 66;
        const float mg = expf(lr * dt * (float)d), an = li * dt * (float)d; pw[2 * d] = mg * cosf(an); pw[2 * d + 1] = mg * sinf(an); }
}

__device__ __forceinline__ void phase_prep2(const Params& p) {
    const size_t gtid = (size_t)blockIdx.x * 512 + tid_fresh(), gthreads = (size_t)gridDim.x * 512;
    for (size_t e = gtid; e < (size_t)2 * 16 * 32 * 256; e += gthreads) { const int l = (int)(e >> 17), g = (int)(e >> 13) & 15, d = (int)(e >> 8) & 31, c = (int)(e >> 4) & 15, c2 = (int)e & 15;
        const float* bb = (const float*)(p.ws + OFF_S5P + (size_t)l * SZ_S5P + S5P_BB) + (size_t)g * 64 * 32; const float* pw = (const float*)(p.ws + OFF_S5P + (size_t)l * SZ_S5P + S5P_PW) + (size_t)g * 64 * 66;
        const float* cr = p.c_re + ((size_t)(l * 16 + g) * 16 + c) * 64; const float* ci = p.c_im + ((size_t)(l * 16 + g) * 16 + c) * 64;
        float acc = 0.f;
        for (int s = 0; s < 64; ++s) { const float pr = pw[s * 66 + 2 * d], pi = pw[s * 66 + 2 * d + 1], br = bb[s * 32 + 2 * c2], bi = bb[s * 32 + 2 * c2 + 1];
            const float xr = pr * br - pi * bi, xi = pr * bi + pi * br; acc += cr[s] * xr - ci[s] * xi; }
        bf16_t* bt = (bf16_t*)(p.ws + OFF_S5M + (size_t)l * SZ_S5M + S5M_BT1) + (size_t)g * 768 * 512; const bf16_t v = f2bf(acc);
        for (int s = 0; s + d < 32; ++s) bt[(size_t)((s + d) * 16 + c) * 512 + s * 16 + c2] = v; }
    for (size_t e = gtid; e < (size_t)2 * 16 * 768 * 32; e += gthreads) { const int s = (int)(e & 31); const int row = (int)((e >> 5) % 768); const int lg = (int)(e / (768 * 32)), l = lg >> 4, g = lg & 15;
        bf16_t* dst = (bf16_t*)(p.ws + OFF_S5M + (size_t)l * SZ_S5M + S5M_BT1) + ((size_t)g * 768 + row) * 512 + s * 16; float f[16];
        if (row < 512) { if (s <= (row >> 4)) continue;
#pragma unroll
            for (int j = 0; j < 16; ++j) f[j] = 0.f; }
        else if (row < 640) { const int q = row - 512, pp = q & 63, im = q >> 6;
            const float* bb = (const float*)(p.ws + OFF_S5P + (size_t)l * SZ_S5P + S5P_BB) + (size_t)(g * 64 + pp) * 32; const float* pw = (const float*)(p.ws + OFF_S5P + (size_t)l * SZ_S5P + S5P_PW) + (size_t)(g * 64 + pp) * 66;
            const float pr = pw[2 * (31 - s)], pi = pw[2 * (31 - s) + 1];
#pragma unroll
            for (int j = 0; j < 16; ++j) { const float br = bb[2 * j], bi = bb[2 * j + 1]; f[j] = im ? (pr * bi + pi * br) : (pr * br - pi * bi); } }
        else {
#pragma unroll
            for (int j = 0; j < 16; ++j) f[j] = 0.f; }
        *(u32x4*)dst = pack8(f); *(u32x4*)(dst + 8) = pack8(f + 8); }
    for (size_t e = gtid; e < (size_t)2 * 16 * 512 * 32; e += gthreads) { const int qo = (int)(e & 31), row = (int)(e >> 5) & 511, lg = (int)(e >> 14), l = lg >> 4, g = lg & 15;
        const int t = row >> 4, c = row & 15; float f[8];
        const float* pw = (const float*)(p.ws + OFF_S5P + (size_t)l * SZ_S5P + S5P_PW) + (size_t)g * 64 * 66;
        const float* cr = p.c_re + ((size_t)(l * 16 + g) * 16 + c) * 64; const float* ci = p.c_im + ((size_t)(l * 16 + g) * 16 + c) * 64;
#pragma unroll
        for (int j = 0; j < 8; ++j) { const int q = qo * 8 + j; float v = 0.f;
            if (q < 128) { const int pp = q & 63; const float pr = pw[pp * 66 + 2 * (t + 1)], pi = pw[pp * 66 + 2 * (t + 1) + 1]; v = q < 64 ? (cr[pp] * pr - ci[pp] * pi) : -(cr[pp] * pi + ci[pp] * pr); }
            f[j] = v; }
        *(u32x4*)((bf16_t*)(p.ws + OFF_S5M + (size_t)l * SZ_S5M + S5M_E) + ((size_t)g * 512 + row) * 256 + qo * 8) = pack8(f); }
}

__device__ __forceinline__ float sum8(const float* f) { return f[0] * f[0] + f[1] * f[1] + f[2] * f[2] + f[3] * f[3] + f[4] * f[4] + f[5] * f[5] + f[6] * f[6] + f[7] * f[7]; }
__device__ __forceinline__ float red8(float v) { v += __shfl_xor(v, 1); v += __shfl_xor(v, 2); v += __shfl_xor(v, 4); return v; }
__device__ __forceinline__ void tile_put(bf16_t* T, int tok, int j, u32x4 w) { unsigned* q = (unsigned*)(T + tok * 66 + 8 * j); q[0] = w.x; q[1] = w.y; q[2] = w.z; q[3] = w.w; }
__device__ __forceinline__ u32x4 tile_get_t(const bf16_t* T, int d, int tj) { unsigned short v[8];
#pragma unroll
    for (int e = 0; e < 8; ++e) v[e] = T[(8 * tj + e) * 66 + d];
    u32x4 w; w.x = v[0] | ((unsigned)v[1] << 16); w.y = v[2] | ((unsigned)v[3] << 16); w.z = v[4] | ((unsigned)v[5] << 16); w.w = v[6] | ((unsigned)v[7] << 16); return w; }

__device__ __forceinline__ void a2_transpose_store(const bf16_t* T, int lane, bf16_t* dstT) {
    const int tl = lane >> 3, j = lane & 7;
#pragma unroll
    for (int m = 0; m < 8; ++m) { const int d = 8 * m + tl; gst16(dstT + (size_t)d * LP + 8 * j, tile_get_t(T, d, j)); }
}
template <bool dry> __device__ __forceinline__ void phase_a2(const Params& p, int l, unsigned char* shm) {
    bf16_t* proj = (bf16_t*)(p.ws + OFF_PROJ);
    bf16_t* vst = (bf16_t*)(p.ws + OFF_VST); bf16_t* vrt = (bf16_t*)(p.ws + OFF_VRT); bf16_t* krt = (bf16_t*)(p.ws + OFF_KRT); bf16_t* ure = (bf16_t*)(p.ws + OFF_URE);
    const float* rot = (const float*)(p.ws + OFF_ROT);
    const int tid = tid_fresh(), wv = __builtin_amdgcn_readfirstlane(tid >> 6), lane = tid & 63, tl = lane >> 3, j = lane & 7;
    bf16_t* T = (bf16_t*)shm + wv * (64 * 66);
    constexpr int cm = dry ? 1023 : 0xffff;
    for (int e = blockIdx.x * 512 + tid; e < MROWS; e += gridDim.x * 512) { ((float*)(p.ws + OFF_SSQD))[e] = 0.f; ((float*)(p.ws + OFF_SSQ))[e] = 0.f; }
    if (!dry) for (int e = blockIdx.x * 512 + tid; e < MROWS * 12; e += gridDim.x * 512) { const int row = e / 12, sl = e - row * 12; float* hs = (float*)(p.ws + OFF_HSS) + e;
        ((float*)(p.ws + OFF_HINV))[(size_t)sl * MROWS + row] = rsqrtf(*hs * (1.0f / 64.0f) + RMS_EPS); *hs = 0.f; }
#pragma unroll 1
    for (int item = blockIdx.x * 8 + wv; item < (MROWS / 64) * 6; item += gridDim.x * 8) {
        const int tile = item / 6, slot = 6 + item - tile * 6, r0 = tile * 64; int b, i0; bi_of(r0, b, i0);
        if (slot < 6) { const int h = slot;
            float gq[8], gk[8];
#pragma unroll
            for (int e = 0; e < 8; ++e) { gq[e] = p.sb_q_g[l * 64 + 8 * j + e] * (0.125f * LOG2E); gk[e] = p.sb_k_g[l * 64 + 8 * j + e]; }
#pragma unroll 4
            for (int q = 0; q < 8; ++q) { const int tok = 8 * q + tl; bf16_t* prow = proj + (size_t)(r0 + tok) * DINP; bf16_t* orow = dry ? (bf16_t*)(p.ws + OFF_MIX) + (size_t)(r0 + tok) * 1024 : prow; float f[8];
                { unpack8(gld16(prow + 64 * h + 8 * j), f); const float inv = rsqrtf(red8(sum8(f)) * (1.0f / 64.0f) + RMS_EPS);
#pragma unroll
                  for (int e = 0; e < 8; ++e) f[e] *= inv * gq[e];
                  gst16(orow + ((64 * h) & cm) + 8 * j, pack8(f)); }
                { unpack8(gld16(prow + 384 + 64 * h + 8 * j), f); const float inv = rsqrtf(red8(sum8(f)) * (1.0f / 64.0f) + RMS_EPS);
#pragma unroll
                  for (int e = 0; e < 8; ++e) f[e] *= inv * gk[e];
                  gst16(orow + ((384 + 64 * h) & cm) + 8 * j, pack8(f)); }
                }
        } else { const int h = slot - 6; const float lg = log_gamma_h(h);
            float gq[8], gk[8];
#pragma unroll
            for (int e = 0; e < 8; ++e) { gq[e] = p.ret_q_g[l * 64 + 8 * j + e]; gk[e] = p.ret_k_g[l * 64 + 8 * j + e]; }
#pragma unroll 2
            for (int q = 0; q < 8; ++q) { const int tok = 8 * q + tl, i = i0 + tok; bf16_t* prow = proj + (size_t)(r0 + tok) * DINP; bf16_t* orow = dry ? (bf16_t*)(p.ws + OFF_MIX) + (size_t)(r0 + tok) * 1024 : prow;
                const float ex = lg * (float)((i & 127) + 1), qd = __expf(ex), kd = 0.125f * __expf(-ex);
                const float* cs = rot + ((size_t)i * 32 + 8 * (j & 3)) * 2; float c[8], sn[8], f[8], o[8];
#pragma unroll
                for (int e = 0; e < 4; ++e) { const f32x4 t = gld16f(cs + 4 * e); c[2 * e] = t.x; sn[2 * e] = t.y; c[2 * e + 1] = t.z; sn[2 * e + 1] = t.w; }
                { unpack8(gld16(prow + 1152 + 64 * h + 8 * j), f); const float inv = rsqrtf(red8(sum8(f)) * (1.0f / 64.0f) + RMS_EPS);
#pragma unroll
                  for (int e = 0; e < 8; ++e) f[e] *= inv * gq[e];
#pragma unroll
                  for (int e = 0; e < 8; ++e) { const float other = __shfl_xor(f[e], 4); o[e] = (j < 4 ? f[e] * c[e] - other * sn[e] : other * sn[e] + f[e] * c[e]) * qd; }
                  gst16(orow + ((1152 + 64 * h) & cm) + 8 * j, pack8(o)); }
                { unpack8(gld16(prow + 1536 + 64 * h + 8 * j), f); const float inv = rsqrtf(red8(sum8(f)) * (1.0f / 64.0f) + RMS_EPS);
#pragma unroll
                  for (int e = 0; e < 8; ++e) f[e] *= inv * gk[e];
#pragma unroll
                  for (int e = 0; e < 8; ++e) { const float other = __shfl_xor(f[e], 4); o[e] = (j < 4 ? f[e] * c[e] - other * sn[e] : other * sn[e] + f[e] * c[e]) * kd; }
                  const u32x4 w = pack8(o); gst16(orow + ((1536 + 64 * h) & cm) + 8 * j, w); tile_put(T, tok, j, w); } }
            __builtin_amdgcn_wave_barrier();
            a2_transpose_store(T, lane, krt + (size_t)(b * 6 + h) * 64 * LP + i0);
            __builtin_amdgcn_wave_barrier();
        }
    }
}

__device__ __forceinline__ bf16x8 ld16(const bf16_t* q) { return *(const bf16x8*)q; }
__device__ __forceinline__ bf16x8 gld16b(const bf16_t* q) { return *(const GAS bf16x8*)q; }
__device__ __forceinline__ bf16x8 gld8x2(const bf16_t* a, const bf16_t* b) { const bf16x4 x = *(const GAS bf16x4*)a, y = *(const GAS bf16x4*)b; bf16x8 r; r[0] = x[0]; r[1] = x[1]; r[2] = x[2]; r[3] = x[3]; r[4] = y[0]; r[5] = y[1]; r[6] = y[2]; r[7] = y[3]; return r; }
__device__ __forceinline__ bf16x8 ld8x2(const bf16_t* a, const bf16_t* b) { const bf16x4 x = *(const bf16x4*)a, y = *(const bf16x4*)b; bf16x8 r; r[0] = x[0]; r[1] = x[1]; r[2] = x[2]; r[3] = x[3]; r[4] = y[0]; r[5] = y[1]; r[6] = y[2]; r[7] = y[3]; return r; }
__device__ __forceinline__ bf16x8 pk8(const f32x16& v, int s) { u32x4 w; w.x = cvt_pk_bf16(v[8 * s + 0], v[8 * s + 1]); w.y = cvt_pk_bf16(v[8 * s + 2], v[8 * s + 3]); w.z = cvt_pk_bf16(v[8 * s + 4], v[8 * s + 5]); w.w = cvt_pk_bf16(v[8 * s + 6], v[8 * s + 7]);
    bf16x8 r; __builtin_memcpy(&r, &w, 16); return r; }

__device__ __forceinline__ void sb_wave(const Params& p, int widx) {
    const bf16_t* proj = (const bf16_t*)(p.ws + OFF_PROJ); const bf16_t* vst = (const bf16_t*)(p.ws + OFF_VST); bf16_t* mix = (bf16_t*)(p.ws + OFF_MIX);
    const int qt = widx % NCH32, bh = widx / NCH32, b = bh / 6, h = bh - b * 6, lane = tid_fresh() & 63, r = lane & 31, hh = lane >> 5;
    const size_t row0 = (size_t)row_of(b, qt * 32); bf16_t* orow = mix + (row0 + r) * 1024 + 64 * h;
    if (qt < 3) {
#pragma unroll
        for (int q = 0; q < 4; ++q) gst16(orow + 32 * hh + 8 * q, (u32x4){0u, 0u, 0u, 0u});
        return; }
    bf16x8 qf[4];
#pragma unroll
    for (int s = 0; s < 4; ++s) qf[s] = gld16b(proj + (row0 + r) * DINP + 64 * h + 16 * s + 8 * hh);
    f32x16 o0, o1;
#pragma unroll
    for (int e = 0; e < 16; ++e) { o0[e] = 0.f; o1[e] = 0.f; }
    float carry = 1.0f; const int qi = qt * 32 + r; const bf16_t* vb = vst + (size_t)bh * 64 * LP;
    const bf16_t* kbase = proj + (size_t)r * DINP + 384 + 64 * h + 8 * hh;
#define SB_KPTR(kt) (kbase + (size_t)row_of(b, (kt) * 32) * DINP)
    const float* hinv = (const float*)(p.ws + OFF_HINV); const float invq = gld4f(hinv + (size_t)h * MROWS + row0 + r);
    const float* ikbase = hinv + (size_t)(6 + h) * MROWS + 4 * hh;
#define SB_IKPTR(kt) (ikbase + (size_t)row_of(b, (kt) * 32))
    f32x4 ik[4], ikn[4];
#pragma unroll
    for (int jj = 0; jj < 4; ++jj) ik[jj] = gld16f(SB_IKPTR(qt) + 8 * jj);
    bf16x8 kf[4], kn[4];
#pragma unroll
    for (int s = 0; s < 4; ++s) kf[s] = gld16b(SB_KPTR(qt) + 16 * s);
    const bf16_t* vrow0 = vb + (size_t)r * LP + 4 * hh; const bf16_t* vrow1 = vrow0 + (size_t)32 * LP;
    bf16x8 va0 = gld8x2(vrow0 + qt * 32, vrow0 + qt * 32 + 8), va1 = gld8x2(vrow0 + qt * 32 + 16, vrow0 + qt * 32 + 24);
    bf16x8 vb0 = gld8x2(vrow1 + qt * 32, vrow1 + qt * 32 + 8), vb1 = gld8x2(vrow1 + qt * 32 + 16, vrow1 + qt * 32 + 24);
#pragma unroll 1
    for (int kt = qt; kt >= 3; --kt) {
        const int ktn = kt > 3 ? kt - 1 : kt;
#pragma unroll
        for (int s = 0; s < 4; ++s) kn[s] = gld16b(SB_KPTR(ktn) + 16 * s);
#pragma unroll
        for (int jj = 0; jj < 4; ++jj) ikn[jj] = gld16f(SB_IKPTR(ktn) + 8 * jj);
        const bf16x8 na0 = gld8x2(vrow0 + ktn * 32, vrow0 + ktn * 32 + 8), na1 = gld8x2(vrow0 + ktn * 32 + 16, vrow0 + ktn * 32 + 24);
        const bf16x8 nb0 = gld8x2(vrow1 + ktn * 32, vrow1 + ktn * 32 + 8), nb1 = gld8x2(vrow1 + ktn * 32 + 16, vrow1 + ktn * 32 + 24);
        f32x16 st;
#pragma unroll
        for (int e = 0; e < 16; ++e) st[e] = 0.f;
#pragma unroll
        for (int s = 0; s < 4; ++s) st = MFMA32(kf[s], qf[s], st);
        float T[4];
        if (kt == qt || kt == 3) {
#pragma unroll
            for (int jj = 0; jj < 4; ++jj) { float suf = 1.0f;
#pragma unroll
                for (int kk = 3; kk >= 0; --kk) { const int reg = 4 * jj + kk, key = kt * 32 + 8 * jj + 4 * hh + kk; const bool valid = key < qi && key >= 112;
                    const float ez = valid ? __builtin_amdgcn_exp2f(fminf(st[reg] * (invq * ik[jj][kk]), 100.0f)) : 0.0f; st[reg] = ez; suf *= 1.0f + ez; }
                T[jj] = suf; }
        } else {
#pragma unroll
            for (int jj = 0; jj < 4; ++jj) { float suf = 1.0f;
#pragma unroll
                for (int kk = 3; kk >= 0; --kk) { const int reg = 4 * jj + kk; const float ez = __builtin_amdgcn_exp2f(fminf(st[reg] * (invq * ik[jj][kk]), 100.0f)); st[reg] = ez; suf *= 1.0f + ez; }
                T[jj] = suf; }
        }
        float Tp[4], PP[4], tail[4];
#pragma unroll
        for (int jj = 0; jj < 4; ++jj) { Tp[jj] = __shfl_xor(T[jj], 32); PP[jj] = T[jj] * Tp[jj]; }
        tail[3] = 1.0f; tail[2] = PP[3]; tail[1] = PP[2] * tail[2]; tail[0] = PP[1] * tail[1];
        f32x16 w;
#pragma unroll
        for (int jj = 0; jj < 4; ++jj) { const float after = carry * tail[jj] * (hh == 0 ? Tp[jj] : 1.0f); float suf = 1.0f;
#pragma unroll
            for (int kk = 3; kk >= 0; --kk) { const int reg = 4 * jj + kk; const float e = st[reg]; suf *= 1.0f + e; w[reg] = e * __builtin_amdgcn_rcpf(after * suf); } }
        carry = carry * PP[0] * tail[0];
        const bf16x8 p0 = pk8(w, 0), p1 = pk8(w, 1);
        o0 = MFMA32(va0, p0, o0); o0 = MFMA32(va1, p1, o0);
        o1 = MFMA32(vb0, p0, o1); o1 = MFMA32(vb1, p1, o1);
#pragma unroll
        for (int s = 0; s < 4; ++s) kf[s] = kn[s];
        va0 = na0; va1 = na1; vb0 = nb0; vb1 = nb1;
#pragma unroll
        for (int jj = 0; jj < 4; ++jj) ik[jj] = ikn[jj];
        if (__all(carry > 4.2950e9f)) break;
    }
#pragma unroll
    for (int jj = 0; jj < 4; ++jj) { u32x2 a, c; a.x = cvt_pk_bf16(o0[4 * jj], o0[4 * jj + 1]); a.y = cvt_pk_bf16(o0[4 * jj + 2], o0[4 * jj + 3]); c.x = cvt_pk_bf16(o1[4 * jj], o1[4 * jj + 1]); c.y = cvt_pk_bf16(o1[4 * jj + 2], o1[4 * jj + 3]);
        gst8(orow + 8 * jj + 4 * hh, a); gst8(orow + 32 + 8 * jj + 4 * hh, c); }
}

__device__ __forceinline__ void ret_item(const Params& p, int l, int bh, unsigned char* shm) {
    const bf16_t* proj = (const bf16_t*)(p.ws + OFF_PROJ); const bf16_t* vrt = (const bf16_t*)(p.ws + OFF_VRT) + (size_t)bh * 64 * LP; const bf16_t* krt = (const bf16_t*)(p.ws + OFF_KRT) + (size_t)bh * 64 * LP;
    bf16_t* mix = (bf16_t*)(p.ws + OFF_MIX);
    const int b = bh / 6, h = bh - b * 6, tid = tid_fresh(), wv = __builtin_amdgcn_readfirstlane(tid >> 6), lane = tid & 63, r = lane & 31, hh = lane >> 5;
    bf16_t* LQ = (bf16_t*)shm; bf16_t* LK = LQ + 128 * 72; bf16_t* LVT = LK + 128 * 72; bf16_t* LKT = LVT + 64 * 136; bf16_t* ST = LKT + 64 * 136;
    for (int e = tid; e < 2 * 64 * 72 / 2; e += 512) ((unsigned*)ST)[e] = 0u;
    const int qrow = tid >> 3, qc = (tid & 7) * 8, trow = tid >> 4, tc = (tid & 15) * 8;
    const bf16_t* gq = proj + (size_t)qrow * DINP + 1152 + 64 * h + qc; const bf16_t* gk = gq + 384;
    const bf16_t* gvt = vrt + (size_t)trow * LP + tc; const bf16_t* gkt = krt + (size_t)trow * LP + tc;
    u32x4 pre[8];
#define RET_ISSUE(n) do { const size_t ro = (size_t)row_of(b, (n) * 128) * DINP; \
        pre[0] = gld16(gq + ro); pre[1] = gld16(gq + ro + (size_t)64 * DINP); pre[2] = gld16(gk + ro); pre[3] = gld16(gk + ro + (size_t)64 * DINP); \
        pre[4] = gld16(gvt + (n) * 128); pre[5] = gld16(gvt + (size_t)32 * LP + (n) * 128); pre[6] = gld16(gkt + (n) * 128); pre[7] = gld16(gkt + (size_t)32 * LP + (n) * 128); } while (0)
#define RET_COMMIT() do { *(u32x4*)(LQ + qrow * 72 + qc) = pre[0]; *(u32x4*)(LQ + (qrow + 64) * 72 + qc) = pre[1]; *(u32x4*)(LK + qrow * 72 + qc) = pre[2]; *(u32x4*)(LK + (qrow + 64) * 72 + qc) = pre[3]; \
        *(u32x4*)(LVT + trow * 136 + tc) = pre[4]; *(u32x4*)(LVT + (trow + 32) * 136 + tc) = pre[5]; *(u32x4*)(LKT + trow * 136 + tc) = pre[6]; *(u32x4*)(LKT + (trow + 32) * 136 + tc) = pre[7]; } while (0)
    RET_ISSUE(0); RET_COMMIT(); RET_ISSUE(1);
    __syncthreads();
    const float lg = log_gamma_h(h), cdec = __expf(lg * 128.0f);
    f32x16 sacc;
#pragma unroll
    for (int e = 0; e < 16; ++e) sacc[e] = 0.f;
    f32x4 ogv[8];
#pragma unroll
    for (int q = 0; q < 8; ++q) ogv[q] = *(const f32x4*)(p.ret_out_g + l * 384 + 64 * h + 32 * (q >> 2) + 8 * (q & 3) + 4 * hh);
#pragma unroll 1
    for (int n = 0; n < LP / 128; ++n) {
        const bf16_t* Sc = ST + (n & 1) * 64 * 72; bf16_t* Sn = ST + ((n & 1) ^ 1) * 64 * 72;
        const size_t row0 = (size_t)row_of(b, n * 128) + 32 * (wv & 3);
        u32x2 gw[8]; f32x16 o0, o1;
        if (wv < 4) {
            const bf16_t* grow = proj + (row0 + r) * DINP + 2304 + 64 * h;
#pragma unroll
            for (int q = 0; q < 8; ++q) gw[q] = gld8(grow + 32 * (q >> 2) + 8 * (q & 3) + 4 * hh);
            bf16x8 qf[4];
#pragma unroll
            for (int s = 0; s < 4; ++s) qf[s] = *(const bf16x8*)(LQ + (32 * wv + r) * 72 + 16 * s + 8 * hh);
#pragma unroll
            for (int e = 0; e < 16; ++e) { o0[e] = 0.f; o1[e] = 0.f; }
            { bf16x8 sa[4], sb[4];
#pragma unroll
              for (int s = 0; s < 4; ++s) { sa[s] = *(const bf16x8*)(Sc + r * 72 + 16 * s + 8 * hh); sb[s] = *(const bf16x8*)(Sc + (32 + r) * 72 + 16 * s + 8 * hh); }
              __builtin_amdgcn_sched_barrier(0);
#pragma unroll
              for (int s = 0; s < 4; ++s) { o0 = MFMA32(sa[s], qf[s], o0); o1 = MFMA32(sb[s], qf[s], o1); } }
#pragma unroll
            for (int kt = 0; kt < 4; ++kt) { if (kt > wv) break;
                bf16x8 kf[4];
#pragma unroll
                for (int s = 0; s < 4; ++s) kf[s] = *(const bf16x8*)(LK + (32 * kt + r) * 72 + 16 * s + 8 * hh);
                const bf16_t* v0 = LVT + r * 136 + kt * 32 + 4 * hh; const bf16_t* v1 = v0 + 32 * 136;
                const bf16x8 va0 = ld8x2(v0, v0 + 8), va1 = ld8x2(v0 + 16, v0 + 24), vb0 = ld8x2(v1, v1 + 8), vb1 = ld8x2(v1 + 16, v1 + 24);
                __builtin_amdgcn_sched_barrier(0);
                f32x16 st;
#pragma unroll
                for (int e = 0; e < 16; ++e) st[e] = 0.f;
#pragma unroll
                for (int s = 0; s < 4; ++s) st = MFMA32(kf[s], qf[s], st);
                if (kt == wv) {
#pragma unroll
                    for (int reg = 0; reg < 16; ++reg) { const int key = 8 * (reg >> 2) + 4 * hh + (reg & 3); st[reg] = key <= r ? st[reg] : 0.f; } }
                const bf16x8 p0 = pk8(st, 0), p1 = pk8(st, 1);
                o0 = MFMA32(va0, p0, o0); o1 = MFMA32(vb0, p0, o1); o0 = MFMA32(va1, p1, o0); o1 = MFMA32(vb1, p1, o1);
            }
        } else {
            const int di = (wv - 4) >> 1, ei = (wv - 4) & 1;
            const bf16_t* kp = LKT + (32 * di + r) * 136 + 8 * hh; const bf16_t* vp = LVT + (32 * ei + r) * 136 + 8 * hh;
#pragma unroll
            for (int s = 0; s < 8; ++s) sacc = MFMA32(*(const bf16x8*)(kp + 16 * s), *(const bf16x8*)(vp + 16 * s), sacc);
#pragma unroll
            for (int e = 0; e < 16; ++e) sacc[e] *= cdec;
#pragma unroll
            for (int jj = 0; jj < 4; ++jj) { u32x2 w; w.x = cvt_pk_bf16(sacc[4 * jj], sacc[4 * jj + 1]); w.y = cvt_pk_bf16(sacc[4 * jj + 2], sacc[4 * jj + 3]);
                *(u32x2*)(Sn + (32 * ei + r) * 72 + 32 * di + 8 * jj + 4 * hh) = w; }
        }
        __syncthreads();
        if (n + 1 < LP / 128) RET_COMMIT();
        if (n + 2 < LP / 128) RET_ISSUE(n + 2);
        if (wv < 4) {
            float ss = 0.f;
#pragma unroll
            for (int e = 0; e < 16; ++e) ss += o0[e] * o0[e] + o1[e] * o1[e];
            ss += __shfl_xor(ss, 32);
            const float inv = rsqrtf(ss * (1.0f / 64.0f) + RMS_EPS);
            bf16_t* orow = mix + (row0 + r) * 1024 + 384 + 64 * h;
#pragma unroll
            for (int t2 = 0; t2 < 2; ++t2)
#pragma unroll
                for (int jj = 0; jj < 4; ++jj) { const int e0 = 32 * t2 + 8 * jj + 4 * hh; const u32x2 gwv = gw[4 * t2 + jj]; const f32x4 gg = ogv[4 * t2 + jj];
                    const float g0 = lo_bf(gwv.x), g1 = hi_bf(gwv.x), g2 = lo_bf(gwv.y), g3 = hi_bf(gwv.y);
                    const float a0 = (t2 ? o1[4 * jj] : o0[4 * jj]) * inv * gg[0] * g0 * sigmoidf_(g0), a1 = (t2 ? o1[4 * jj + 1] : o0[4 * jj + 1]) * inv * gg[1] * g1 * sigmoidf_(g1);
                    const float a2 = (t2 ? o1[4 * jj + 2] : o0[4 * jj + 2]) * inv * gg[2] * g2 * sigmoidf_(g2), a3 = (t2 ? o1[4 * jj + 3] : o0[4 * jj + 3]) * inv * gg[3] * g3 * sigmoidf_(g3);
                    u32x2 w; w.x = cvt_pk_bf16(a0, a1); w.y = cvt_pk_bf16(a2, a3); gst8(orow + e0, w); }
        }
        __syncthreads();
    }
#undef RET_ISSUE
#undef RET_COMMIT
}

__device__ __forceinline__ void phase_b_items(const Params& p, int l, int ci, unsigned char* shm, volatile int* s_itemp, int only = 0) {
    unsigned* ctr = (unsigned*)(p.ws + OFF_CTR) + ci;
    constexpr int N_RET = NBATCH * 6, N_SB = NBATCH * 6 * NCH32 / 16;
#pragma unroll 1
    for (;;) {
        __syncthreads();
        if (threadIdx.x == 0) *s_itemp = (int)atomicAdd(ctr, 1u);
        __syncthreads();
        const int item = __builtin_amdgcn_readfirstlane(*s_itemp);
        if (item >= N_RET + N_SB) break;
        if (item < N_RET) { if (only != 2) ret_item(p, l, item, shm); }
        else if (only != 1) { const int w0 = (item - N_RET) * 16 + __builtin_amdgcn_readfirstlane(tid_fresh() >> 6); sb_wave(p, w0); sb_wave(p, w0 + 8); }
    }
}

__device__ __forceinline__ void phase_s5_scan(const Params& p, int l) {
    const int gt = ((int)gridDim.x - 1 - (int)blockIdx.x) * 512 + tid_fresh(); if (gt < 16 * 16 * 64) {
    const int pp = gt & 63, b = (gt >> 6) & 15, g = gt >> 10;
    const float* pw = (const float*)(p.ws + OFF_S5P + (size_t)l * SZ_S5P + S5P_PW) + (size_t)(g * 64 + pp) * 66; const float ar = pw[64], ai = pw[65];
    const float* xe = (const float*)(p.ws + OFF_XEND) + ((size_t)g * S5ROWS + b * NCH32) * 128; bf16_t* xs = (bf16_t*)(p.ws + OFF_XST) + ((size_t)g * S5ROWS + b * NCH32) * 256;
    float xr = 0.f, xi = 0.f;
#pragma unroll 1
    for (int n0 = 0; n0 < NCH32; n0 += 12) { float er[12], ei[12];
#pragma unroll
        for (int q = 0; q < 12; ++q) { er[q] = xe[(n0 + q) * 128 + pp]; ei[q] = xe[(n0 + q) * 128 + 64 + pp]; }
#pragma unroll
        for (int q = 0; q < 12; ++q) { const int n = n0 + q; xs[n * 256 + pp] = f2bf(xr); xs[n * 256 + 64 + pp] = f2bf(xi); xs[n * 256 + 128 + pp] = 0; xs[n * 256 + 192 + pp] = 0;
            const float nr = ar * xr - ai * xi + er[q], ni = ar * xi + ai * xr + ei[q]; xr = nr; xi = ni; } }
    }
}

__device__ __forceinline__ Params fresh(Params p) { asm volatile("" : "+s"(p.ws), "+s"(p.out), "+s"(p.x)); return p; }
__global__ void __launch_bounds__(512, 2) hymba_fwd(Params p0) {
    extern __shared__ __attribute__((aligned(16))) unsigned char shm[];
    cg::grid_group grid = cg::this_grid();
    PG8_LAS unsigned char* lds = (PG8_LAS unsigned char*)shm;
    __shared__ uint4 s_misc;
    if (threadIdx.x == 0) s_misc = make_uint4(0u, 0u, 0u, 0u);
    __syncthreads();
    const XcdBarrier xb = xcd_barrier_post((unsigned*)(p0.ws + OFF_BAR), (volatile LAS unsigned*)&s_misc);
    for (int rep = 0; rep < ((DUP_MASK >> 3) & 1) + 1; ++rep) {
    phase_prep1(fresh(p0), shm);
    if (__builtin_expect(p0.ws == nullptr, 0)) grid.sync();
    xcd_barrier(xb);
    phase_prep2(fresh(p0));
    xcd_barrier(xb); }
    for (int rep = 0; rep < EXTRA_SYNCS; ++rep) xcd_barrier(xb);
#pragma unroll 1
    for (int l0 = 0; l0 < 2; ++l0) {
        for (int rep = 0; rep < ((DUP_MASK >> 0) & 1) + 1; ++rep) {
        { const Params p = fresh(p0); const int l = sgpr_fresh(l0), G = sgpr_fresh((int)gridDim.x), c = sgpr_fresh((int)blockIdx.x); const unsigned char* wl = p.ws + OFF_W + (size_t)l * SZ_WL;
          StaticOrder S; S.init(MROWS, DINP, G, c); EpiProj E{(bf16_t*)(p.ws + OFF_PROJ), (const float*)(p.ws + OFF_SSQ), (bf16_t*)(p.ws + OFF_URE), (bf16_t*)(p.ws + OFF_VST), (bf16_t*)(p.ws + OFF_VRT), (float*)(p.ws + OFF_HSS), p.sb_q_g + l * 64, p.sb_k_g + l * 64};
          gemm_phase<EpiProj, StaticOrder>(lds, Gemm{(const bf16_t*)(p.ws + OFF_HB), (const bf16_t*)(wl + WL_IN), MROWS, DINP, 1024}, S, E, nullptr); }
        if (rep + 1 < ((DUP_MASK >> 0) & 1) + 1) xcd_barrier(xb); }
        xcd_barrier(xb);
#if (DUP_MASK >> 5) & 1
        phase_a2<true>(fresh(p0), sgpr_fresh(l0), shm); xcd_barrier(xb);
#endif
        phase_a2<false>(fresh(p0), sgpr_fresh(l0), shm);
        xcd_barrier(xb);
        for (int rep = 0; rep < ((DUP_MASK >> 2) & 1) + 1; ++rep) {
        if (!(B_ONLY && rep == 0 && ((DUP_MASK >> 2) & 1))) { const Params p = fresh(p0); const int l = sgpr_fresh(l0), G = sgpr_fresh((int)gridDim.x), c = sgpr_fresh((int)blockIdx.x); const unsigned char* sm = p.ws + OFF_S5M + (size_t)l * SZ_S5M;
          BatchedOrder S; S.init(16, 9, 3, G, c); EpiS5a E{(bf16_t*)(p.ws + OFF_YLOC), (float*)(p.ws + OFF_XEND)};
          gemm_phase<EpiS5a, BatchedOrder>(lds, Gemm{(const bf16_t*)(p.ws + OFF_URE), (const bf16_t*)(sm + S5M_BT1), 16 * S5ROWS, 16 * 768, 512}, S, E, nullptr); }
        xcd_barrier(xb);
        phase_s5_scan(fresh(p0), sgpr_fresh(l0));
        phase_b_items(fresh(p0), sgpr_fresh(l0), sgpr_fresh(l0 + 2 * rep), shm, (volatile int*)&s_misc.z, (rep == 0 && ((DUP_MASK >> 2) & 1)) ? B_ONLY : 0);
        if (rep + 1 < ((DUP_MASK >> 2) & 1) + 1) xcd_barrier(xb); }
        xcd_barrier(xb);
        for (int rep = 0; rep < ((DUP_MASK >> 4) & 1) + 1; ++rep) {
        { const Params p = fresh(p0); const int l = sgpr_fresh(l0), G = sgpr_fresh((int)gridDim.x), c = sgpr_fresh((int)blockIdx.x); const unsigned char* sm = p.ws + OFF_S5M + (size_t)l * SZ_S5M;
          BatchedOrder S; S.init(16, 9, 2, G, c); EpiS5b E{(const bf16_t*)(p.ws + OFF_YLOC), (const bf16_t*)(p.ws + OFF_URE), p.s5_d + l * 256, (bf16_t*)(p.ws + OFF_YBUF)};
          gemm_phase<EpiS5b, BatchedOrder>(lds, Gemm{(const bf16_t*)(p.ws + OFF_XST), (const bf16_t*)(sm + S5M_E), 16 * S5ROWS, 16 * 512, 256}, S, E, nullptr); }
        xcd_barrier(xb);
        { const Params p = fresh(p0); const int l = sgpr_fresh(l0), G = sgpr_fresh((int)gridDim.x), c = sgpr_fresh((int)blockIdx.x); const unsigned char* wl = p.ws + OFF_W + (size_t)l * SZ_WL;
          StaticOrder S; S.init(l == 1 ? NREAL : MROWS, 256, G, c); EpiGlu E{(const bf16_t*)(p.ws + OFF_YBUF), (bf16_t*)(p.ws + OFF_MIX)};
          gemm_phase<EpiGlu, StaticOrder>(lds, Gemm{(const bf16_t*)(p.ws + OFF_YBUF), (const bf16_t*)(wl + WL_GLU), MROWS, 256, 256}, S, E, nullptr); }
        if (rep + 1 < ((DUP_MASK >> 4) & 1) + 1) xcd_barrier(xb); }
        xcd_barrier(xb);
        { const Params p = fresh(p0); const int l = sgpr_fresh(l0), G = sgpr_fresh((int)gridDim.x), c = sgpr_fresh((int)blockIdx.x); const unsigned char* wl = p.ws + OFF_W + (size_t)l * SZ_WL;
          StaticOrder S; S.init(l == 1 ? NREAL : MROWS, 1024, G, c); EpiRes E{(bf16_t*)(p.ws + OFF_HB), (float*)(p.ws + OFF_SSQD), p.out, 0};
          gemm_phase<EpiRes, StaticOrder>(lds, Gemm{(const bf16_t*)(p.ws + OFF_MIX), (const bf16_t*)(wl + WL_OUT), MROWS, 1024, 1024}, S, E, nullptr); }
        xcd_barrier(xb);
        for (int rep = 0; rep < ((DUP_MASK >> 1) & 1) + 1; ++rep) {
        { const Params p = fresh(p0); const int l = sgpr_fresh(l0), G = sgpr_fresh((int)gridDim.x), c = sgpr_fresh((int)blockIdx.x); const unsigned char* wl = p.ws + OFF_W + (size_t)l * SZ_WL;
          StaticOrder S; S.init(l == 1 ? NREAL : MROWS, 5632, G, c); EpiAct E{(bf16_t*)(p.ws + OFF_ACT), (const float*)(p.ws + OFF_SSQD)};
          if (DUP_NOP && rep == 0) { EpiNop E0{(float*)(p.ws + OFF_CTR + 128)}; gemm_phase<EpiNop, StaticOrder>(lds, Gemm{(const bf16_t*)(p.ws + OFF_HB), (const bf16_t*)(wl + WL_GU), MROWS, 5632, 1024}, S, E0, nullptr); }
          else gemm_phase<EpiAct, StaticOrder>(lds, Gemm{(const bf16_t*)(p.ws + OFF_HB), (const bf16_t*)(wl + WL_GU), MROWS, 5632, 1024}, S, E, nullptr); }
        if (rep + 1 < ((DUP_MASK >> 1) & 1) + 1) xcd_barrier(xb); }
        xcd_barrier(xb);
        { const Params p = fresh(p0); const int l = sgpr_fresh(l0), G = sgpr_fresh((int)gridDim.x), c = sgpr_fresh((int)blockIdx.x); const unsigned char* wl = p.ws + OFF_W + (size_t)l * SZ_WL;
          StaticOrder S; S.init(l == 1 ? NREAL : MROWS, 1024, G, c); EpiRes E{(bf16_t*)(p.ws + OFF_HB), (float*)(p.ws + OFF_SSQ), p.out, l == 1 ? 1 : 0};
          gemm_phase<EpiRes, StaticOrder>(lds, Gemm{(const bf16_t*)(p.ws + OFF_ACT), (const bf16_t*)(wl + WL_DN), MROWS, 1024, DFF}, S, E, nullptr); }
        xcd_barrier(xb);
    }
}

extern "C" void kernel_launch(void* const* d_in, const int* in_sizes, int n_in, void* d_out, int out_size, void* d_ws, size_t ws_size, hipStream_t stream) {
    constexpr size_t kDynLds = STAGE_BYTES;
    static int grid_blocks = 0;
    if (!grid_blocks) {
        hipFuncSetAttribute((const void*)hymba_fwd, hipFuncAttributeMaxDynamicSharedMemorySize, (int)kDynLds);
        int dev = 0, cus = 0, per_cu = 0;
        hipGetDevice(&dev);
        hipDeviceGetAttribute(&cus, hipDeviceAttributeMultiprocessorCount, dev);
        hipOccupancyMaxActiveBlocksPerMultiprocessor(&per_cu, hymba_fwd, 512, kDynLds);
        if (per_cu > 1) per_cu = 1;
        grid_blocks = cus * per_cu;
    }
    Params p{};
    const float** f = (const float**)&p;
    for (int i = 0; i < 23; ++i) f[i] = (const float*)d_in[i];
    p.out = (float*)d_out; p.ws = (unsigned char*)d_ws;
    hipMemsetAsync((unsigned char*)d_ws + OFF_BAR, 0, (size_t)XCD_BAR_WORDS_C * 4, stream);
    void* args[] = {&p};
    hipError_t e = hipLaunchCooperativeKernel((void*)hymba_fwd, dim3(grid_blocks), dim3(512), args, kDynLds, stream);
    if (e != hipSuccess) fprintf(stderr, "cooperative launch failed: %s (grid %d)\n", hipGetErrorString(e), grid_blocks);
}
```

```cpp
#include <hip/hip_runtime.h>
#include <hip/hip_cooperative_groups.h>
#include <cstdio>
namespace cg = cooperative_groups;
#ifndef DUP_MASK
#define DUP_MASK 0
#endif
#ifndef DUP_NOP
#define DUP_NOP 0
#endif
#ifndef B_ONLY
#define B_ONLY 0
#endif
#ifndef EXTRA_SYNCS
#define EXTRA_SYNCS 0
#endif

namespace pg8 {
#define PG8_LAS __attribute__((address_space(3)))
typedef unsigned short bf16_t;
typedef short bf16x8 __attribute__((ext_vector_type(8)));
typedef float f32x4 __attribute__((ext_vector_type(4)));
typedef unsigned u32x4 __attribute__((ext_vector_type(4)));
__device__ __forceinline__ int tid_fresh() { int t = threadIdx.x; asm volatile("" : "+v"(t)); return t; }
__device__ __forceinline__ int sgpr_fresh(int v) { asm volatile("" : "+s"(v)); return v; }
constexpr int BM = 256, BK = 64, HALF = 128, HTB = HALF * BK * 2  , STAGE_BYTES = 8 * HTB, NXCD = 8, WGM = 8;

__host__ __device__ __forceinline__ int lds_byte(int r, int c) { const int st = (r >> 4) * 2 + (c >> 5), rr = r & 15, cc = c & 31, ob = rr * 64 + cc * 2; return st * 1024 + (ob ^ (((ob >> 9) & 1) << 5)); }
__host__ __device__ __forceinline__ void stage_rc(int b, int& R, int& C) { const int st = b / 1024, sb = b % 1024, swz = sb ^ (((sb >> 9) & 1) << 5); R = (st >> 1) * 16 + swz / 64; C = (st & 1) * 32 + (swz % 64) / 2; }
__host__ __device__ __forceinline__ int perm32(int rho) { const int n = rho >> 4, i = rho & 15; return 8 * (i >> 2) + 4 * n + (i & 3); }

struct Unit { int pm, pn; };
struct Gemm { const bf16_t* A; const bf16_t* Bt; int M, N, K; };

struct StaticOrder {
    int nM, nN, nwg, G, c;
    __host__ __device__ void init(int M, int N, int G_, int c_) { nM = M / BM; nN = N / BM; nwg = nM * nN; G = G_; c = c_; }
    __host__ __device__ bool next(int i, Unit& u) const {
        const long L = (long)i * G + c; if (L >= nwg) return false;
        int wgid = (int)L; { const int q = nwg / NXCD, r = nwg % NXCD, xcd = wgid % NXCD, off = wgid / NXCD; wgid = (xcd < r ? xcd * (q + 1) : r * (q + 1) + (xcd - r) * q) + off; }
        const int nig = WGM * nN, gid = wgid / nig, fm = gid * WGM, gsz = (nM - fm) < WGM ? (nM - fm) : WGM;
        u.pm = fm + ((wgid % nig) % gsz); u.pn = (wgid % nig) / gsz; return true;
    }
    __device__ __forceinline__ void a_ready(const Unit&) const {}
    __device__ __forceinline__ void done(const Unit&) const {}
};
__device__ __forceinline__ unsigned cvt_pk_bf16(float lo, float hi) { unsigned r; asm volatile("v_cvt_pk_bf16_f32 %0, %1, %2" : "=v"(r) : "v"(lo), "v"(hi)); return r; }

template <class Epi, class Sched, bool STAMP = false>
__device__ __forceinline__ void gemm_phase(PG8_LAS unsigned char* lds, const Gemm g, const Sched& S, const Epi& E, unsigned long long* stamps) {
    const int tid = tid_fresh(), wid = __builtin_amdgcn_readfirstlane(tid >> 6), lane = tid & 63, wr = wid >> 2, wc = wid & 3, fr = lane & 15, fq = lane >> 4;
    const int K = g.K, nt = K / BK;
    int ts_lo = 0, ts_hi = 0, nts = 0; const unsigned long long rt_entry = STAMP ? (unsigned long long)wall_clock64() : 0ull;
#define PG8_STAMP() do { if (STAMP && wid == 0 && nts < 64) { const unsigned long long _c = (unsigned long long)clock64(); \
        ts_lo = (lane == nts) ? (int)(unsigned)_c : ts_lo; ts_hi = (lane == nts) ? (int)(unsigned)(_c >> 32) : ts_hi; ++nts; } } while (0)
    PG8_STAMP();
    unsigned voffA[2], voffB[2];
#pragma unroll
    for (int i = 0; i < 2; ++i) { int R, C; stage_rc(tid * 16 + i * 8192, R, C); const int Rb = Epi::PERM ? ((R & ~31) + perm32(R & 31)) : R;
        voffA[i] = (unsigned)(R * K + C) * 2u; voffB[i] = (unsigned)(Rb * K + C) * 2u; }
    const size_t kstep = (size_t)(BK * 2);
    const size_t hstep = (size_t)HALF * K * 2;
    const size_t tstep = 2 * hstep;
    const unsigned ldsw = (unsigned)wid * 1024u;
    const int aoff = lds_byte(wr * 64 + fr, fq * 8), boff = lds_byte(wc * 32 + fr, fq * 8);
#define PG8_SA(b, h) (((b) * 2 + (h)) * HTB)
#define PG8_SB(b, h) ((4 + (b) * 2 + (h)) * HTB)
#define PG8_STAGE(bufoff, gbase, voff) do { _Pragma("unroll") for (int _i = 0; _i < 2; ++_i) \
        __builtin_amdgcn_global_load_lds((const unsigned*)((const char*)(gbase) + (voff)[_i]), (PG8_LAS unsigned*)(lds + (bufoff) + ldsw + _i * 8192), 16, 0, 0); } while (0)
#define PG8_LDA(dst, b, h) do { _Pragma("unroll") for (int m = 0; m < 4; ++m) _Pragma("unroll") for (int k = 0; k < 2; ++k) dst[m][k] = *(const PG8_LAS bf16x8*)(lds + PG8_SA(b, h) + aoff + m * 2048 + k * 1024); } while (0)
#define PG8_LDB(dst, b, h) do { _Pragma("unroll") for (int n = 0; n < 2; ++n) _Pragma("unroll") for (int k = 0; k < 2; ++k) dst[n][k] = *(const PG8_LAS bf16x8*)(lds + PG8_SB(b, h) + boff + n * 2048 + k * 1024); } while (0)
#define PG8_MMA(ai, bj, At, Bt) do { __builtin_amdgcn_s_setprio(1); _Pragma("unroll") for (int m = 0; m < 4; ++m) _Pragma("unroll") for (int n = 0; n < 2; ++n) _Pragma("unroll") for (int k = 0; k < 2; ++k) \
        acc[ai][bj][m][n] = __builtin_amdgcn_mfma_f32_16x16x32_bf16(Bt[n][k], At[m][k], acc[ai][bj][m][n], 0, 0, 0); __builtin_amdgcn_s_setprio(0); } while (0)
#define PG8_WAIT_V(n) asm volatile("s_waitcnt vmcnt(" #n ")" ::: "memory")
#define PG8_WAIT_L(n) asm volatile("s_waitcnt lgkmcnt(" #n ")" ::: "memory")
#define PG8_BAR __builtin_amdgcn_s_barrier()
#define PG8_SCHED __builtin_amdgcn_sched_barrier(0)
    Unit cur, nxt; int ui = 0;
    if (!S.next(0, cur)) return;
    f32x4 acc[2][2][4][2];
#pragma unroll
    for (int a = 0; a < 2; ++a)
#pragma unroll
        for (int b = 0; b < 2; ++b)
#pragma unroll
            for (int m = 0; m < 4; ++m)
#pragma unroll
                for (int n = 0; n < 2; ++n) acc[a][b][m][n] = (f32x4){0.f, 0.f, 0.f, 0.f};
    bf16x8 At[4][2], B0[2][2], B1[2][2];
    const char* cA = (const char*)g.A + (size_t)cur.pm * tstep; const char* cB = (const char*)g.Bt + (size_t)cur.pn * tstep;
    S.a_ready(cur);
    E.prefetch(cur, wr, fr);
    PG8_STAGE(PG8_SB(0, 0), cB, voffB); PG8_STAGE(PG8_SA(0, 0), cA, voffA); PG8_STAGE(PG8_SB(0, 1), cB + hstep, voffB); PG8_STAGE(PG8_SA(0, 1), cA + hstep, voffA);
    if (wr == 1) PG8_BAR;
    PG8_WAIT_V(4); PG8_BAR;
    PG8_STAGE(PG8_SB(1, 0), cB + kstep, voffB); PG8_STAGE(PG8_SA(1, 0), cA + kstep, voffA); PG8_STAGE(PG8_SB(1, 1), cB + hstep + kstep, voffB);
    PG8_WAIT_V(6); PG8_BAR;
    PG8_STAMP();
    for (;;) {
        const bool has_next = S.next(ui + 1, nxt);
        const char* nA = has_next ? (const char*)g.A + (size_t)nxt.pm * tstep : cA; const char* nB = has_next ? (const char*)g.Bt + (size_t)nxt.pn * tstep : cB;
#pragma unroll 1
        for (int t = 0; t < nt; t += 2) {
            const bool last = (t == nt - 2);
            const char* a1 = cA + (size_t)(t + 1) * kstep;
            const char* a2 = last ? nA : cA + (size_t)(t + 2) * kstep; const char* b2 = last ? nB : cB + (size_t)(t + 2) * kstep;
            const char* a3 = a2 + kstep; const char* b3 = b2 + kstep;
            if (last && has_next) S.a_ready(nxt);
            PG8_LDB(B0, 0, 0); PG8_SCHED; PG8_LDA(At, 0, 0); PG8_STAGE(PG8_SA(1, 1), a1 + hstep, voffA);
            PG8_WAIT_L(8); PG8_BAR; PG8_WAIT_L(0); PG8_MMA(0, 0, At, B0); PG8_BAR; PG8_SCHED;
            PG8_LDB(B1, 0, 1); PG8_STAGE(PG8_SB(0, 0), b2, voffB);
            PG8_BAR; PG8_WAIT_L(0); PG8_MMA(0, 1, At, B1); PG8_BAR;
            PG8_LDA(At, 0, 1); PG8_STAGE(PG8_SA(0, 0), a2, voffA);
            PG8_BAR; PG8_WAIT_L(0); PG8_MMA(1, 0, At, B0); PG8_BAR; PG8_SCHED;
            PG8_STAGE(PG8_SB(0, 1), b2 + hstep, voffB);
            PG8_WAIT_V(6); PG8_BAR; PG8_MMA(1, 1, At, B1); PG8_BAR;
            PG8_LDB(B0, 1, 0); PG8_SCHED; PG8_LDA(At, 1, 0); PG8_STAGE(PG8_SA(0, 1), a2 + hstep, voffA);
            PG8_WAIT_L(8); PG8_BAR; PG8_WAIT_L(0); PG8_MMA(0, 0, At, B0); PG8_BAR; PG8_SCHED;
            PG8_LDB(B1, 1, 1); PG8_STAGE(PG8_SB(1, 0), b3, voffB);
            PG8_BAR; PG8_WAIT_L(0); PG8_MMA(0, 1, At, B1); PG8_BAR;
            PG8_LDA(At, 1, 1); PG8_STAGE(PG8_SA(1, 0), a3, voffA);
            PG8_BAR; PG8_WAIT_L(0); PG8_MMA(1, 0, At, B0); PG8_BAR; PG8_SCHED;
            PG8_STAGE(PG8_SB(1, 1), b3 + hstep, voffB);
            PG8_WAIT_V(6); PG8_BAR; PG8_MMA(1, 1, At, B1); PG8_BAR;
        }
        PG8_STAMP();
        if constexpr (!Epi::AFTER_DRAIN) { E(acc, cur, wr, wc, fr, fq); if (has_next) E.prefetch(nxt, wr, fr); S.done(cur); }
        PG8_STAMP();
        if (!has_next) break;
#pragma unroll
        for (int a = 0; a < 2; ++a)
#pragma unroll
            for (int b = 0; b < 2; ++b)
#pragma unroll
                for (int m = 0; m < 4; ++m)
#pragma unroll
                    for (int n = 0; n < 2; ++n) acc[a][b][m][n] = (f32x4){0.f, 0.f, 0.f, 0.f};
        cur = nxt; cA = nA; cB = nB; ++ui;
    }
    PG8_WAIT_V(0);
    if (wr == 0) PG8_BAR;
    PG8_BAR;
    if constexpr (Epi::AFTER_DRAIN) { E.fused(acc, cur, wr, wc, fr, fq, lds, wid, lane); S.done(cur); }
    PG8_STAMP();
    if (STAMP && wid == 0) { stamps[lane] = lane < nts ? (((unsigned long long)(unsigned)ts_hi << 32) | (unsigned)ts_lo) : 0ull;
        if (lane == 62) stamps[62] = rt_entry; if (lane == 63) stamps[63] = (unsigned long long)wall_clock64(); }
#undef PG8_STAMP
#undef PG8_SA
#undef PG8_SB
#undef PG8_STAGE
#undef PG8_LDA
#undef PG8_LDB
#undef PG8_MMA
#undef PG8_WAIT_V
#undef PG8_WAIT_L
#undef PG8_BAR
#undef PG8_SCHED
}
}
using namespace pg8;
typedef short bf16x4 __attribute__((ext_vector_type(4)));
typedef float f32x16 __attribute__((ext_vector_type(16)));
typedef unsigned u32x2 __attribute__((ext_vector_type(2)));
typedef float f32x2_t __attribute__((ext_vector_type(2)));

constexpr int DM = 1024, NBATCH = 16, SEQ = 4096, LP = 4224, MROWS = NBATCH * LP, DINP = 3072, DFF = 2816;
constexpr int NCH32 = LP / 32;
constexpr int S5ROWS = 2304;
constexpr int XCD_BAR_WORDS_C = 3456;
constexpr float RMS_EPS = 1e-6f, LOG2E = 1.4426950408889634f;

constexpr size_t SZ_HB = (size_t)MROWS * 1024 * 2;
constexpr size_t OFF_HB = 0;
constexpr size_t SZ_URE = (size_t)16 * S5ROWS * 512 * 2;
constexpr size_t SZ_XEND = (size_t)16 * S5ROWS * 128 * 4;
constexpr size_t SZ_XST = (size_t)16 * S5ROWS * 256 * 2;
constexpr size_t OFF_PROJ = OFF_HB + SZ_HB;
constexpr size_t SZ_PROJ = (size_t)MROWS * DINP * 2;
constexpr size_t OFF_ACT = OFF_PROJ;
constexpr size_t SZ_T = (size_t)MROWS * 384 * 2;
constexpr size_t OFF_VST = OFF_PROJ + SZ_PROJ, OFF_VRT = OFF_VST + SZ_T, OFF_KRT = OFF_VRT + SZ_T;
constexpr size_t OFF_MIX = OFF_KRT + SZ_T;
constexpr size_t OFF_W = OFF_MIX + SZ_HB;
constexpr size_t WL_IN = 0, WL_OUT = (size_t)DINP * 1024 * 2, WL_GU = WL_OUT + (size_t)1024 * 1024 * 2, WL_DN = WL_GU + (size_t)5632 * 1024 * 2,
                 WL_GLU = WL_DN + (size_t)1024 * DFF * 2, SZ_WL = WL_GLU + (size_t)256 * 256 * 2;
constexpr size_t OFF_S5M = OFF_W + 2 * SZ_WL;
constexpr size_t S5M_BT1 = 0, S5M_E = (size_t)16 * 768 * 512 * 2, SZ_S5M = S5M_E + (size_t)16 * 512 * 256 * 2;
constexpr size_t OFF_SSQ = OFF_S5M + 2 * SZ_S5M;
constexpr size_t OFF_SSQD = OFF_SSQ + (size_t)MROWS * 4;
constexpr size_t OFF_HSS = OFF_SSQ + (size_t)MROWS * 2 * 4;
constexpr size_t OFF_HMETA = OFF_SSQ + (size_t)MROWS * 16 * 4;
constexpr size_t OFF_HINV = OFF_HMETA;
constexpr size_t OFF_ROT = OFF_HMETA + (size_t)NBATCH * 128 * 1024 * 4;
constexpr size_t OFF_S5P = OFF_ROT + (size_t)LP * 32 * 2 * 4;
constexpr size_t S5P_BB = 0, S5P_PW = (size_t)16 * 64 * 16 * 2 * 4, SZ_S5P = S5P_PW + (size_t)16 * 64 * 33 * 2 * 4;
constexpr size_t OFF_CTR = OFF_S5P + 2 * SZ_S5P;
constexpr size_t OFF_BAR = OFF_CTR + 256;
constexpr size_t OFF_URE = OFF_BAR + 16384;
constexpr size_t OFF_YLOC = OFF_URE + SZ_URE;
constexpr size_t OFF_XEND = OFF_YLOC + SZ_URE;
constexpr size_t OFF_XST = OFF_XEND + SZ_XEND;
constexpr size_t OFF_YBUF = OFF_VST;
constexpr size_t WS_NEED = OFF_XST + SZ_XST;
static_assert(WS_NEED <= (size_t)1024 * 1024 * 1024, "workspace too large");
static_assert((size_t)MROWS * 256 * 2 <= SZ_T, "ybuf must fit in the VsT region");

constexpr int NREAL = NBATCH * SEQ;
__device__ __forceinline__ int row_of(int b, int i) { return i >= 128 ? b * SEQ + (i - 128) : NREAL + b * 128 + i; }
__device__ __forceinline__ void bi_of(int row, int& b, int& i) { if (row < NREAL) { b = row >> 12; i = (row & (SEQ - 1)) + 128; } else { b = (row - NREAL) >> 7; i = row & 127; } }

struct Params {
    const float *x, *meta, *norm1_g, *w_in, *sb_q_g, *sb_k_g, *ret_q_g, *ret_k_g, *ret_out_g, *lam_re, *lam_im, *log_dt, *b_re, *b_im, *c_re, *c_im, *s5_d, *w_glu,
        *w_out, *norm2_g, *w_gate, *w_up, *w_down;
    float* out;
    unsigned char* ws;
};

#define GAS __attribute__((address_space(1)))
__device__ __forceinline__ void gst16(void* q, u32x4 v) { *(GAS u32x4*)q = v; }
__device__ __forceinline__ void gst16f(void* q, f32x4 v) { *(GAS f32x4*)q = v; }
__device__ __forceinline__ u32x4 gld16(const void* q) { return *(const GAS u32x4*)q; }
__device__ __forceinline__ void gst8(void* q, u32x2 v) { *(GAS u32x2*)q = v; }
__device__ __forceinline__ u32x2 gld8(const void* q) { return *(const GAS u32x2*)q; }
__device__ __forceinline__ f32x4 gld16f(const void* q) { return *(const GAS f32x4*)q; }
__device__ __forceinline__ float gld4f(const void* q) { return *(const GAS float*)q; }
__device__ __forceinline__ void gatomic_addf(float* q, float v) { __hip_atomic_fetch_add((GAS float*)q, v, __ATOMIC_RELAXED, __HIP_MEMORY_SCOPE_AGENT); }
__device__ __forceinline__ float bf2f(bf16_t v) { return __uint_as_float(((unsigned)v) << 16); }
__device__ __forceinline__ bf16_t f2bf(float f) { unsigned u = __float_as_uint(f); u += 0x7FFFu + ((u >> 16) & 1u); return (bf16_t)(u >> 16); }
__device__ __forceinline__ float lo_bf(unsigned w) { return __uint_as_float(w << 16); }
__device__ __forceinline__ float hi_bf(unsigned w) { return __uint_as_float(w & 0xffff0000u); }
__device__ __forceinline__ u32x4 pack8(const float* f) { u32x4 w; w.x = cvt_pk_bf16(f[0], f[1]); w.y = cvt_pk_bf16(f[2], f[3]); w.z = cvt_pk_bf16(f[4], f[5]); w.w = cvt_pk_bf16(f[6], f[7]); return w; }
__device__ __forceinline__ void unpack8(u32x4 w, float* f) { f[0] = lo_bf(w.x); f[1] = hi_bf(w.x); f[2] = lo_bf(w.y); f[3] = hi_bf(w.y); f[4] = lo_bf(w.z); f[5] = hi_bf(w.z); f[6] = lo_bf(w.w); f[7] = hi_bf(w.w); }
__device__ __forceinline__ float log_gamma_h(int h) { const float x = __builtin_amdgcn_exp2f(-5.0f - (float)h); return -x * (1.0f + x * (0.5f + x * (0.33333334f + x * (0.25f + x * 0.2f)))); }
__device__ __forceinline__ float sigmoidf_(float v) { return __builtin_amdgcn_rcpf(1.0f + __builtin_amdgcn_exp2f(-LOG2E * v)); }
__device__ __forceinline__ float gelu_tanh(float y) { const float t = (1.5957691216057308f * LOG2E) * (y + 0.044715f * y * y * y); return y * __builtin_amdgcn_rcpf(1.0f + __builtin_amdgcn_exp2f(-t)); }
#define MFMA32(a, b, c) __builtin_amdgcn_mfma_f32_32x32x16_bf16((a), (b), (c), 0, 0, 0)

struct BatchedOrder {
    int nPm, nPn, nwg, G, c;
    __device__ void init(int nG, int nPm_, int nPn_, int G_, int c_) { nPm = nPm_; nPn = nPn_; nwg = nG * nPm_ * nPn_; G = G_; c = c_; }
    __device__ bool next(int i, Unit& u) const {
        const long L = (long)i * G + c; if (L >= nwg) return false;
        const int per = nPm * nPn, g = (int)L / per, rem = (int)L % per; u.pm = g * nPm + rem / nPn; u.pn = g * nPn + rem % nPn; return true;
    }
    __device__ __forceinline__ void a_ready(const Unit&) const {}
    __device__ __forceinline__ void done(const Unit&) const {}
};

__device__ __forceinline__ float row_rs(const float* ssq, int row) { return rsqrtf(gld4f(ssq + row) * (1.0f / 1024.0f) + RMS_EPS); }

struct EpiProj {
    static constexpr bool PERM = true, AFTER_DRAIN = false;
    bf16_t* O; const float* ssq; bf16_t* ure; bf16_t* vst; bf16_t* vrt; float* hss; const float* qg; const float* kg; mutable float rsn[8]; mutable float tqc[8]; mutable int tq_ready;
    __device__ __forceinline__ void prefetch(const Unit& u, int wr, int fr) const { const int row0 = u.pm * BM + wr * 64 + fr;
        if (!tq_ready) { tq_ready = 1; const int ln = tid_fresh() & 63, wcq = (tid_fresh() >> 6) & 3, d0 = (wcq * 32 + 8 * (ln >> 4)) & 63;
#pragma unroll
            for (int e = 0; e < 8; ++e) { const float gi = __builtin_amdgcn_rcpf(gld4f(qg + d0 + e) * gld4f(kg + d0 + e) * (0.125f * LOG2E)); tqc[e] = gi * gi; } }
#pragma unroll
        for (int q = 0; q < 8; ++q) rsn[q] = gld4f(ssq + row0 + (q >> 2) * HALF + (q & 3) * 16); }
    __device__ __forceinline__ void operator()(const f32x4 (&acc)[2][2][4][2], const Unit& u, int wr, int wc, int fr, int fq) const {
        const int row0 = u.pm * BM + wr * 64 + fr, col0 = u.pn * BM + wc * 32 + 8 * fq; float rsv[8];
#pragma unroll
        for (int q = 0; q < 8; ++q) rsv[q] = rsqrtf(rsn[q] * (1.0f / 1024.0f) + RMS_EPS);
        float tq[2][8];
#pragma unroll
        for (int bj = 0; bj < 2; ++bj) { const int cb = u.pn * BM + bj * HALF, d0 = (col0 + bj * HALF) & 63;
#pragma unroll
            for (int e = 0; e < 8; ++e) tq[bj][e] = cb < 384 ? tqc[e] : 1.0f; (void)d0; }
#pragma unroll
        for (int ai = 0; ai < 2; ++ai)
#pragma unroll
            for (int m = 0; m < 4; ++m) { const int row = row0 + ai * HALF + m * 16; const float rs = rsv[ai * 4 + m]; bf16_t* rowp = O + (size_t)row * DINP + col0;
#pragma unroll
                for (int bj = 0; bj < 2; ++bj) { const int col = col0 + bj * HALF, cb = u.pn * BM + bj * HALF; if (cb >= 2944) continue;
                    const f32x4 v0 = acc[ai][bj][m][0] * rs, v1 = acc[ai][bj][m][1] * rs;
                    u32x4 w; w.x = cvt_pk_bf16(v0[0], v0[1]); w.y = cvt_pk_bf16(v0[2], v0[3]); w.z = cvt_pk_bf16(v1[0], v1[1]); w.w = cvt_pk_bf16(v1[2], v1[3]);
                    const bool isv = (cb >= 768 && cb < 1152) || (cb >= 1920 && cb < 2304);
                    if (cb >= 2688) { int b, i; bi_of(row, b, i); const int c0 = col - 2688, g = c0 >> 4;
                        gst16(ure + ((size_t)g * S5ROWS + b * NCH32 + (i >> 5)) * 512 + (i & 31) * 16 + (c0 & 15), w); }
                    else if (isv) { int b, i; bi_of(row, b, i); const int c0 = col - (cb < 1152 ? 768 : 1920);
                        GAS bf16_t* dst = (GAS bf16_t*)(cb < 1152 ? vst : vrt) + ((size_t)(b * 6 + (c0 >> 6)) * 64 + (c0 & 63)) * LP + i;
                        dst[0] = (bf16_t)w.x; dst[LP] = (bf16_t)(w.x >> 16); dst[2 * LP] = (bf16_t)w.y; dst[3 * LP] = (bf16_t)(w.y >> 16);
                        dst[4 * LP] = (bf16_t)w.z; dst[5 * LP] = (bf16_t)(w.z >> 16); dst[6 * LP] = (bf16_t)w.w; dst[7 * LP] = (bf16_t)(w.w >> 16); }
                    else { gst16(rowp + bj * HALF, w);
                        if (cb < 768) {
                            float part = v0[0] * v0[0] * tq[bj][0] + v0[1] * v0[1] * tq[bj][1] + v0[2] * v0[2] * tq[bj][2] + v0[3] * v0[3] * tq[bj][3] + v1[0] * v1[0] * tq[bj][4] + v1[1] * v1[1] * tq[bj][5] + v1[2] * v1[2] * tq[bj][6] + v1[3] * v1[3] * tq[bj][7];
                            part += __shfl_xor(part, 16); part += __shfl_xor(part, 32);
                            if (fq == 0) gatomic_addf(hss + (size_t)row * 12 + (col >> 6), part); } } } }
    }
};

struct EpiAct {
    static constexpr bool PERM = true, AFTER_DRAIN = false;
    bf16_t* O; const float* ssq; mutable float rsn[8];
    __device__ __forceinline__ void prefetch(const Unit& u, int wr, int fr) const { const int row0 = u.pm * BM + wr * 64 + fr;
#pragma unroll
        for (int q = 0; q < 8; ++q) rsn[q] = gld4f(ssq + row0 + (q >> 2) * HALF + (q & 3) * 16); }
    __device__ __forceinline__ void operator()(const f32x4 (&acc)[2][2][4][2], const Unit& u, int wr, int wc, int fr, int fq) const {
        const int row0 = u.pm * BM + wr * 64 + fr, col0 = u.pn * HALF + wc * 32 + 8 * fq; float rsv[8];
#pragma unroll
        for (int q = 0; q < 8; ++q) rsv[q] = rsqrtf(rsn[q] * (1.0f / 1024.0f) + RMS_EPS);
#pragma unroll
        for (int ai = 0; ai < 2; ++ai)
#pragma unroll
            for (int m = 0; m < 4; ++m) { const int row = row0 + ai * HALF + m * 16; const float rs = rsv[ai * 4 + m]; float o[8];
#pragma unroll
                for (int n = 0; n < 2; ++n)
#pragma unroll
                    for (int j = 0; j < 4; ++j) { const float g = acc[ai][0][m][n][j] * rs, up = acc[ai][1][m][n][j] * rs; o[n * 4 + j] = g * sigmoidf_(g) * up; }
                gst16(O + (size_t)row * DFF + col0, pack8(o)); }
    }
};

struct EpiNop { static constexpr bool PERM = true, AFTER_DRAIN = false; float* sink;
    __device__ __forceinline__ void prefetch(const Unit&, int, int) const {}
    __device__ __forceinline__ void operator()(const f32x4 (&acc)[2][2][4][2], const Unit& u, int wr, int wc, int fr, int fq) const { f32x4 t = (f32x4){0.f, 0.f, 0.f, 0.f};
#pragma unroll
        for (int a = 0; a < 2; ++a)
#pragma unroll
            for (int b = 0; b < 2; ++b)
#pragma unroll
                for (int m = 0; m < 4; ++m) { t += acc[a][b][m][0]; t += acc[a][b][m][1]; }
        if (t.x + t.y + t.z + t.w == 123.456f) sink[0] = 1.0f; } };

struct EpiRes {
    static constexpr bool PERM = true, AFTER_DRAIN = false;
    bf16_t* hb; float* ssq; float* out; int last;
    __device__ __forceinline__ void prefetch(const Unit&, int, int) const {}
    __device__ __forceinline__ void operator()(const f32x4 (&acc)[2][2][4][2], const Unit& u, int wr, int wc, int fr, int fq) const {
        const int row0 = u.pm * BM + wr * 64 + fr, col0 = u.pn * BM + wc * 32 + 8 * fq;
#pragma unroll
        for (int ai = 0; ai < 2; ++ai) {
            u32x4 hv[4][2];
#pragma unroll
            for (int m = 0; m < 4; ++m)
#pragma unroll
                for (int bj = 0; bj < 2; ++bj) hv[m][bj] = gld16(hb + (size_t)(row0 + ai * HALF + m * 16) * 1024 + col0 + bj * HALF);
            __builtin_amdgcn_sched_barrier(0);
#pragma unroll
            for (int m = 0; m < 4; ++m) { const int row = row0 + ai * HALF + m * 16; int b, i; bi_of(row, b, i);
                bf16_t* hp = hb + (size_t)row * 1024 + col0; const float valid = i >= 112 ? 1.0f : 0.0f; float part = 0.f;
#pragma unroll
                for (int bj = 0; bj < 2; ++bj) { float h[8]; unpack8(hv[m][bj], h);
                    const f32x4 v0 = ((f32x4){h[0], h[1], h[2], h[3]} + acc[ai][bj][m][0]) * valid, v1 = ((f32x4){h[4], h[5], h[6], h[7]} + acc[ai][bj][m][1]) * valid;
                    if (!last) { u32x4 w; w.x = cvt_pk_bf16(v0[0], v0[1]); w.y = cvt_pk_bf16(v0[2], v0[3]); w.z = cvt_pk_bf16(v1[0], v1[1]); w.w = cvt_pk_bf16(v1[2], v1[3]);
                        gst16(hp + bj * HALF, w);
                        part += v0[0] * v0[0] + v0[1] * v0[1] + v0[2] * v0[2] + v0[3] * v0[3] + v1[0] * v1[0] + v1[1] * v1[1] + v1[2] * v1[2] + v1[3] * v1[3]; }
                    else if (i >= 128) { float* d = out + ((size_t)b * SEQ + (i - 128)) * 1024 + col0 + bj * HALF; gst16f(d, v0); gst16f(d + 4, v1); } }
                if (!last) { part += __shfl_xor(part, 16); part += __shfl_xor(part, 32); if (fq == 0) gatomic_addf(ssq + row, part); } }
            __builtin_amdgcn_sched_barrier(0); }
    }
};

struct EpiS5a {
    static constexpr bool PERM = true, AFTER_DRAIN = false;
    bf16_t* yloc; float* xend;
    __device__ __forceinline__ void prefetch(const Unit&, int, int) const {}
    __device__ __forceinline__ void operator()(const f32x4 (&acc)[2][2][4][2], const Unit& u, int wr, int wc, int fr, int fq) const {
        const int g = u.pm / 9, prow = u.pm - g * 9, pcol = u.pn - g * 3;
        const int rr0 = prow * BM + wr * 64 + fr, cc0 = wc * 32 + 8 * fq;
#pragma unroll
        for (int ai = 0; ai < 2; ++ai)
#pragma unroll
            for (int m = 0; m < 4; ++m) { const int rr = rr0 + ai * HALF + m * 16; const size_t grow = (size_t)g * S5ROWS + rr;
                if (pcol < 2) {
#pragma unroll
                    for (int bj = 0; bj < 2; ++bj) { const f32x4 v0 = acc[ai][bj][m][0], v1 = acc[ai][bj][m][1];
                        u32x4 w; w.x = cvt_pk_bf16(v0[0], v0[1]); w.y = cvt_pk_bf16(v0[2], v0[3]); w.z = cvt_pk_bf16(v1[0], v1[1]); w.w = cvt_pk_bf16(v1[2], v1[3]);
                        gst16(yloc + grow * 512 + pcol * 256 + bj * HALF + cc0, w); }
                } else { float* xp = xend + grow * 128 + cc0; gst16f(xp, acc[ai][0][m][0]); gst16f(xp + 4, acc[ai][0][m][1]); } }
    }
};

struct EpiS5b {
    static constexpr bool PERM = true, AFTER_DRAIN = false;
    const bf16_t* yloc; const bf16_t* ure; const float* dskip; bf16_t* ybuf;
    __device__ __forceinline__ void prefetch(const Unit&, int, int) const {}
    __device__ __forceinline__ void operator()(const f32x4 (&acc)[2][2][4][2], const Unit& u, int wr, int wc, int fr, int fq) const {
        const int g = u.pm / 9, prow = u.pm - g * 9, pcol = u.pn - g * 2;
        const int rr0 = prow * BM + wr * 64 + fr, cc0 = pcol * 256 + wc * 32 + 8 * fq, c = cc0 & 15;
        const f32x4 d0 = gld16f(dskip + 16 * g + c), d1 = gld16f(dskip + 16 * g + c + 4);
#pragma unroll
        for (int ai = 0; ai < 2; ++ai)
#pragma unroll
            for (int mp = 0; mp < 2; ++mp) {
                u32x4 ylv[2][2], uuv[2][2];
#pragma unroll
                for (int mm = 0; mm < 2; ++mm)
#pragma unroll
                    for (int bj = 0; bj < 2; ++bj) { const int rr = rr0 + ai * HALF + (2 * mp + mm) * 16; const size_t grow = (size_t)g * S5ROWS + (rr < NBATCH * NCH32 ? rr : 0);
                        ylv[mm][bj] = gld16(yloc + grow * 512 + cc0 + bj * HALF); uuv[mm][bj] = gld16(ure + grow * 512 + cc0 + bj * HALF); }
                __builtin_amdgcn_sched_barrier(0);
#pragma unroll
                for (int mm = 0; mm < 2; ++mm) { const int m = 2 * mp + mm, rr = rr0 + ai * HALF + m * 16; if (rr >= NBATCH * NCH32) continue;
                    const int b = rr / NCH32, n = rr - b * NCH32;
#pragma unroll
                    for (int bj = 0; bj < 2; ++bj) { const int cc = cc0 + bj * HALF, t = cc >> 4; const size_t trow = (size_t)row_of(b, n * 32 + t);
                        float yl[8], uu[8], o[8]; unpack8(ylv[mm][bj], yl); unpack8(uuv[mm][bj], uu);
#pragma unroll
                        for (int j = 0; j < 4; ++j) { o[j] = gelu_tanh(acc[ai][bj][m][0][j] + yl[j] + d0[j] * uu[j]); o[4 + j] = gelu_tanh(acc[ai][bj][m][1][j] + yl[4 + j] + d1[j] * uu[4 + j]); }
                        gst16(ybuf + trow * 256 + 16 * g + c, pack8(o)); } }
                __builtin_amdgcn_sched_barrier(0); }
    }
};

struct EpiGlu {
    static constexpr bool PERM = true, AFTER_DRAIN = false;
    const bf16_t* ybuf; bf16_t* mix;
    __device__ __forceinline__ void prefetch(const Unit&, int, int) const {}
    __device__ __forceinline__ void operator()(const f32x4 (&acc)[2][2][4][2], const Unit& u, int wr, int wc, int fr, int fq) const {
        const int row0 = u.pm * BM + wr * 64 + fr, col0 = wc * 32 + 8 * fq;
#pragma unroll
        for (int ai = 0; ai < 2; ++ai) {
            u32x4 yv[4][2];
#pragma unroll
            for (int m = 0; m < 4; ++m)
#pragma unroll
                for (int bj = 0; bj < 2; ++bj) yv[m][bj] = gld16(ybuf + (size_t)(row0 + ai * HALF + m * 16) * 256 + col0 + bj * HALF);
            __builtin_amdgcn_sched_barrier(0);
#pragma unroll
            for (int m = 0; m < 4; ++m) { const size_t row = row0 + ai * HALF + m * 16;
#pragma unroll
                for (int bj = 0; bj < 2; ++bj) { const int col = col0 + bj * HALF; float y[8], o[8]; unpack8(yv[m][bj], y);
#pragma unroll
                    for (int j = 0; j < 4; ++j) { o[j] = y[j] * sigmoidf_(acc[ai][bj][m][0][j]); o[4 + j] = y[4 + j] * sigmoidf_(acc[ai][bj][m][1][j]); }
                    gst16(mix + row * 1024 + 768 + col, pack8(o)); } }
            __builtin_amdgcn_sched_barrier(0); }
    }
};

#define XB_TMO      128
#define XB_XCNT(j)  (256  + 64 * (j))
#define XB_XSUB(j)  (1280 + 64 * (j))
#define XB_XGEN(j)  (2304 + 64 * (j))
#define XB_TOP      3328
#define XB_TOPGEN   3392
#define XCD_BAR_WORDS 3456
#define XB_SPIN_CAP (1u << 18)
#define LAS __attribute__((address_space(3)))

__device__ __forceinline__ unsigned xb_ld(unsigned* p)              { return __hip_atomic_load(p, __ATOMIC_RELAXED, __HIP_MEMORY_SCOPE_AGENT); }
__device__ __forceinline__ unsigned xb_add(unsigned* p, unsigned v) { return __hip_atomic_fetch_add(p, v, __ATOMIC_RELAXED, __HIP_MEMORY_SCOPE_AGENT); }
__device__ __forceinline__ unsigned xb_xcc_id() { return (unsigned)__builtin_amdgcn_s_getreg((3 << 11) | 20) & 0xFu; }
#define XB_SPIN(cond, bar) do { unsigned _sp = 0; while (cond) { __builtin_amdgcn_s_sleep(1); \
    if ((++_sp & 255u) == 0u) { if (xb_ld(&(bar)[XB_TMO])) break; if (_sp > XB_SPIN_CAP) { atomicAdd(&(bar)[XB_TMO], 1u); break; } } } } while (0)
struct XcdBarrier {
    unsigned* bar; unsigned x;
    volatile LAS unsigned* st;
};

__device__ __forceinline__ XcdBarrier xcd_barrier_post(unsigned* bar, volatile LAS unsigned* st) {
    XcdBarrier b; b.bar = bar; b.x = xb_xcc_id(); b.st = st;
    if (threadIdx.x == 0) (void)xb_add(&bar[XB_XCNT(b.x)], 1u);
    return b;
}
__device__ __forceinline__ void xcd_barrier_complete(unsigned* bar, unsigned x, unsigned& nloc, unsigned& nx) {
    const unsigned G = gridDim.x * gridDim.y * gridDim.z;
    unsigned sum, cnt, mine, sp = 0u;
    for (;;) {
        sum = 0u; cnt = 0u; mine = 0u;
#pragma unroll
        for (unsigned j = 0; j < 16; ++j) { const unsigned c = xb_ld(&bar[XB_XCNT(j)]); sum += c; cnt += (c > 0u) ? 1u : 0u; mine = (j == x) ? c : mine; }
        if (sum == G) break;
        __builtin_amdgcn_s_sleep(1);
        if ((++sp & 255u) == 0u) { if (xb_ld(&bar[XB_TMO])) break; if (sp > XB_SPIN_CAP) { atomicAdd(&bar[XB_TMO], 1u); break; } }
    }
    nloc = mine > 0u ? mine : 1u; nx = cnt > 0u ? cnt : 1u;
}

__device__ __forceinline__ void xcd_barrier(const XcdBarrier& b) {
    asm volatile("s_waitcnt vmcnt(0)" ::: "memory");
    __syncthreads();
    if (threadIdx.x == 0) {
        unsigned* bar = b.bar;
        __builtin_amdgcn_s_waitcnt(0);
        unsigned nloc = b.st[0], nx = b.st[1];
        if (nloc == 0u) { xcd_barrier_complete(bar, b.x, nloc, nx); b.st[0] = nloc; b.st[1] = nx; }
        const unsigned old = xb_add(&bar[XB_XSUB(b.x)], 1u);
        const unsigned gen = old / nloc;
        if (old + 1u == (gen + 1u) * nloc) {
            __builtin_amdgcn_fence(__ATOMIC_RELEASE, "agent");
            asm volatile("s_waitcnt vmcnt(0)" ::: "memory");
            const unsigned og = xb_add(&bar[XB_TOP], 1u);
            const unsigned tg = og / nx;
            if (og + 1u == (tg + 1u) * nx) xb_add(&bar[XB_TOPGEN], 1u);
            else XB_SPIN(xb_ld(&bar[XB_TOPGEN]) == tg, bar);
            __builtin_amdgcn_fence(__ATOMIC_ACQUIRE, "agent");
            xb_add(&bar[XB_XGEN(b.x)], 1u);
            asm volatile("s_waitcnt vmcnt(0)" ::: "memory");
        } else {
            XB_SPIN(xb_ld(&bar[XB_XGEN(b.x)]) == gen, bar);
            __builtin_amdgcn_fence(__ATOMIC_ACQUIRE, "agent");
            asm volatile("s_waitcnt vmcnt(0)" ::: "memory");
        }
    }
    __syncthreads();
}

#ifndef STAG_ALL_US
#define STAG_ALL_US 0
#endif
__device__ __forceinline__ void phase_stagger(int nwg, int G, int c, int unit_us) {
    const int nmax = (nwg + G - 1) / G, mine = nwg > c ? (nwg - c + G - 1) / G : 0;
    const unsigned h = ((unsigned)c * 2654435761u) >> 24;
    int us = (mine < nmax) ? (int)((unsigned)unit_us * h) >> 8 : (int)((unsigned)STAG_ALL_US * h) >> 8;
    if (us > 0) { const unsigned long long t0 = __builtin_amdgcn_s_memrealtime(), ticks = (unsigned long long)us * 100ull;
        while (__builtin_amdgcn_s_memrealtime() - t0 < ticks) __builtin_amdgcn_s_sleep(16); }
}

__device__ __forceinline__ void wtile(const float* W, int N, int k0, int n0, const float* gk, bf16_t* Wt, int ldk, int mode, int lane, float cs = 1.0f) {
    const int n = n0 + lane, drow = mode == 0 ? n : ((n >> 7) * 256 + (mode == 2 ? 128 : 0) + (n & 127));
    bf16_t* dst = Wt + (size_t)drow * ldk + k0; const float* src = W + (size_t)k0 * N + n;
#pragma unroll
    for (int hf = 0; hf < 2; ++hf) { float f[32];
#pragma unroll
        for (int kk = 0; kk < 32; ++kk) f[kk] = src[(size_t)(32 * hf + kk) * N];
        if (gk) {
#pragma unroll
            for (int kk = 0; kk < 32; ++kk) f[kk] *= gk[k0 + 32 * hf + kk] * cs; }
#pragma unroll
        for (int q = 0; q < 4; ++q) *(u32x4*)(dst + 32 * hf + 8 * q) = pack8(f + 8 * q); }
}

__device__ __forceinline__ void phase_prep1(const Params& p, unsigned char* shm) {
    const int tid = tid_fresh(), nb = gridDim.x, bid = blockIdx.x;
    if (bid == 0 && tid < 64) ((unsigned*)(p.ws + OFF_CTR))[tid] = 0u;
    for (size_t e = (size_t)bid * 512 + tid; e < (size_t)MROWS * 12; e += (size_t)nb * 512) ((float*)(p.ws + OFF_HSS))[e] = 0.f;
    constexpr int T_IN = 16 * 46, T_OUT = 16 * 16, T_G = 16 * 44, T_D = 44 * 16, T_GLU = 16, T_L = T_IN + T_OUT + 2 * T_G + T_D + T_GLU;
    const int wvp = tid >> 6, lanep = tid & 63;
#pragma unroll 1
    for (int it = bid * 8 + wvp; it < 2 * T_L; it += nb * 8) {
        const int l = it / T_L; int r = it - l * T_L; unsigned char* wl = p.ws + OFF_W + (size_t)l * SZ_WL;
        if (r < T_IN) { const int n0 = (r % 46) * 64; const float cs = n0 < 384 ? p.sb_q_g[l * 64 + lanep] * p.sb_k_g[l * 64 + lanep] * (0.125f * LOG2E) : 1.0f;
            wtile(p.w_in + (size_t)l * 1024 * 2944, 2944, (r / 46) * 64, n0, p.norm1_g + l * 1024, (bf16_t*)(wl + WL_IN), 1024, 0, lanep, cs); continue; } r -= T_IN;
        if (r < T_OUT) { wtile(p.w_out + (size_t)l * 1024 * 1024, 1024, (r / 16) * 64, (r % 16) * 64, nullptr, (bf16_t*)(wl + WL_OUT), 1024, 0, lanep); continue; } r -= T_OUT;
        if (r < T_G) { wtile(p.w_gate + (size_t)l * 1024 * DFF, DFF, (r / 44) * 64, (r % 44) * 64, p.norm2_g + l * 1024, (bf16_t*)(wl + WL_GU), 1024, 1, lanep); continue; } r -= T_G;
        if (r < T_G) { wtile(p.w_up + (size_t)l * 1024 * DFF, DFF, (r / 44) * 64, (r % 44) * 64, p.norm2_g + l * 1024, (bf16_t*)(wl + WL_GU), 1024, 2, lanep); continue; } r -= T_G;
        if (r < T_D) { wtile(p.w_down + (size_t)l * DFF * 1024, 1024, (r / 16) * 64, (r % 16) * 64, nullptr, (bf16_t*)(wl + WL_DN), DFF, 0, lanep); continue; } r -= T_D;
        wtile(p.w_glu + (size_t)l * 256 * 256, 256, (r / 4) * 64, (r % 4) * 64, nullptr, (bf16_t*)(wl + WL_GLU), 256, 0, lanep);
    }
    const size_t gtid = (size_t)bid * 512 + tid, gthreads = (size_t)nb * 512;
    for (size_t e = gtid; e < (size_t)2 * 128 * 128; e += gthreads) { const int l = (int)(e / (128 * 128)), q = (int)(e % (128 * 128));
        *(u32x4*)(p.ws + OFF_W + (size_t)l * SZ_WL + WL_IN + ((size_t)2944 * 1024 + (size_t)q * 8) * 2) = (u32x4){0u, 0u, 0u, 0u}; }
    { bf16_t* hb = (bf16_t*)(p.ws + OFF_HB); float* ssq = (float*)(p.ws + OFF_SSQ);
      const int wv = tid >> 6, lane = tid & 63;
      auto srcp = [&](int row) -> const float* { int b, i; bi_of(row, b, i); return i < 112 ? nullptr : (i < 128 ? p.meta + (size_t)(i - 112) * 1024 : p.x + ((size_t)b * SEQ + (i - 128)) * 1024); };
      f32x4 cur[4], nxt[4]; int row = bid * 8 + wv;
      { const float* src = row < MROWS ? srcp(row) : nullptr;
#pragma unroll
        for (int q = 0; q < 4; ++q) cur[q] = src ? *(const GAS f32x4*)(src + q * 256 + lane * 4) : (f32x4){0.f, 0.f, 0.f, 0.f}; }
#pragma unroll 1
      for (; row < MROWS; row += nb * 8) {
          const int rn = row + nb * 8; const float* srcn = rn < MROWS ? srcp(rn) : nullptr;
#pragma unroll
          for (int q = 0; q < 4; ++q) nxt[q] = srcn ? *(const GAS f32x4*)(srcn + q * 256 + lane * 4) : (f32x4){0.f, 0.f, 0.f, 0.f};
          float part = 0.f;
#pragma unroll
          for (int q = 0; q < 4; ++q) { const int c = q * 256 + lane * 4; const f32x4 v = cur[q];
              part += v.x * v.x + v.y * v.y + v.z * v.z + v.w * v.w;
              u32x2 w; w.x = cvt_pk_bf16(v.x, v.y); w.y = cvt_pk_bf16(v.z, v.w); gst8(hb + (size_t)row * 1024 + c, w); }
#pragma unroll
          for (int o = 32; o >= 1; o >>= 1) part += __shfl_xor(part, o);
          if (lane == 0) ssq[row] = part;
#pragma unroll
          for (int q = 0; q < 4; ++q) cur[q] = nxt[q]; } }
    { float* rot = (float*)(p.ws + OFF_ROT);
      for (size_t e = gtid; e < (size_t)LP * 32; e += gthreads) { const int i = (int)(e >> 5), f = (int)(e & 31);
          const float inv = powf(10000.0f, -(float)f / 32.0f), ang = (float)(i - 112) * inv; rot[2 * e] = cosf(ang); rot[2 * e + 1] = sinf(ang); } }
    for (size_t e = gtid; e < (size_t)2 * 16 * 64; e += gthreads) { const int l = (int)(e >> 10), gp = (int)(e & 1023), g = gp >> 6;
        const float lr = p.lam_re[l * 1024 + gp], li = p.lam_im[l * 1024 + gp], dt = expf(p.log_dt[l * 16 + g]);
        const float mag = expf(lr * dt), ar = mag * cosf(li * dt), ai = mag * sinf(li * dt), den = lr * lr + li * li;
        const float fr = ((ar - 1.0f) * lr + ai * li) / den, fi = (ai * lr - (ar - 1.0f) * li) / den;
        float* bb = (float*)(p.ws + OFF_S5P + (size_t)l * SZ_S5P + S5P_BB) + (size_t)gp * 32;
        for (int c = 0; c < 16; ++c) { const float br = p.b_re[((size_t)l * 1024 + gp) * 16 + c], bi = p.b_im[((size_t)l * 1024 + gp) * 16 + c]; bb[2 * c] = fr * br - fi * bi; bb[2 * c + 1] = fr * bi + fi * br; } }
    for (size_t e = gtid; e < (size_t)2 * 16 * 64 * 33; e += gthreads) { const int d = (int)(e % 33), lgp = (int)(e / 33), l = lgp >> 10, gp = lgp & 1023, g = gp >> 6;
        const float lr = p.lam_re[l * 1024 + gp], li = p.lam_im[l * 1024 + gp], dt = expf(p.log_dt[l * 16 + g]);
        float* pw = (float*)(p.ws + OFF_S5P + (size_t)l * SZ_S5P + S5P_PW) + (size_t)gp * 66;
        const float mg = expf(lr * dt * (float)d), an = li * dt * (float)d; pw[2 * d] = mg * cosf(an); pw[2 * d + 1] = mg * sinf(an); }
}

__device__ __forceinline__ void phase_prep2(const Params& p) {
    const size_t gtid = (size_t)blockIdx.x * 512 + tid_fresh(), gthreads = (size_t)gridDim.x * 512;
    for (size_t e = gtid; e < (size_t)2 * 16 * 32 * 256; e += gthreads) { const int l = (int)(e >> 17), g = (int)(e >> 13) & 15, d = (int)(e >> 8) & 31, c = (int)(e >> 4) & 15, c2 = (int)e & 15;
        const float* bb = (const float*)(p.ws + OFF_S5P + (size_t)l * SZ_S5P + S5P_BB) + (size_t)g * 64 * 32; const float* pw = (const float*)(p.ws + OFF_S5P + (size_t)l * SZ_S5P + S5P_PW) + (size_t)g * 64 * 66;
        const float* cr = p.c_re + ((size_t)(l * 16 + g) * 16 + c) * 64; const float* ci = p.c_im + ((size_t)(l * 16 + g) * 16 + c) * 64;
        float acc = 0.f;
        for (int s = 0; s < 64; ++s) { const float pr = pw[s * 66 + 2 * d], pi = pw[s * 66 + 2 * d + 1], br = bb[s * 32 + 2 * c2], bi = bb[s * 32 + 2 * c2 + 1];
            const float xr = pr * br - pi * bi, xi = pr * bi + pi * br; acc += cr[s] * xr - ci[s] * xi; }
        bf16_t* bt = (bf16_t*)(p.ws + OFF_S5M + (size_t)l * SZ_S5M + S5M_BT1) + (size_t)g * 768 * 512; const bf16_t v = f2bf(acc);
        for (int s = 0; s + d < 32; ++s) bt[(size_t)((s + d) * 16 + c) * 512 + s * 16 + c2] = v; }
    for (size_t e = gtid; e < (size_t)2 * 16 * 768 * 32; e += gthreads) { const int s = (int)(e & 31); const int row = (int)((e >> 5) % 768); const int lg = (int)(e / (768 * 32)), l = lg >> 4, g = lg & 15;
        bf16_t* dst = (bf16_t*)(p.ws + OFF_S5M + (size_t)l * SZ_S5M + S5M_BT1) + ((size_t)g * 768 + row) * 512 + s * 16; float f[16];
        if (row < 512) { if (s <= (row >> 4)) continue;
#pragma unroll
            for (int j = 0; j < 16; ++j) f[j] = 0.f; }
        else if (row < 640) { const int q = row - 512, pp = q & 63, im = q >> 6;
            const float* bb = (const float*)(p.ws + OFF_S5P + (size_t)l * SZ_S5P + S5P_BB) + (size_t)(g * 64 + pp) * 32; const float* pw = (const float*)(p.ws + OFF_S5P + (size_t)l * SZ_S5P + S5P_PW) + (size_t)(g * 64 + pp) * 66;
            const float pr = pw[2 * (31 - s)], pi = pw[2 * (31 - s) + 1];
#pragma unroll
            for (int j = 0; j < 16; ++j) { const float br = bb[2 * j], bi = bb[2 * j + 1]; f[j] = im ? (pr * bi + pi * br) : (pr * br - pi * bi); } }
        else {
#pragma unroll
            for (int j = 0; j < 16; ++j) f[j] = 0.f; }
        *(u32x4*)dst = pack8(f); *(u32x4*)(dst + 8) = pack8(f + 8); }
    for (size_t e = gtid; e < (size_t)2 * 16 * 512 * 32; e += gthreads) { const int qo = (int)(e & 31), row = (int)(e >> 5) & 511, lg = (int)(e >> 14), l = lg >> 4, g = lg & 15;
        const int t = row >> 4, c = row & 15; float f[8];
        const float* pw = (const float*)(p.ws + OFF_S5P + (size_t)l * SZ_S5P + S5P_PW) + (size_t)g * 64 * 66;
        const float* cr = p.c_re + ((size_t)(l * 16 + g) * 16 + c) * 64; const float* ci = p.c_im + ((size_t)(l * 16 + g) * 16 + c) * 64;
#pragma unroll
        for (int j = 0; j < 8; ++j) { const int q = qo * 8 + j; float v = 0.f;
            if (q < 128) { const int pp = q & 63; const float pr = pw[pp * 66 + 2 * (t + 1)], pi = pw[pp * 66 + 2 * (t + 1) + 1]; v = q < 64 ? (cr[pp] * pr - ci[pp] * pi) : -(cr[pp] * pi + ci[pp] * pr); }
            f[j] = v; }
        *(u32x4*)((bf16_t*)(p.ws + OFF_S5M + (size_t)l * SZ_S5M + S5M_E) + ((size_t)g * 512 + row) * 256 + qo * 8) = pack8(f); }
}

__device__ __forceinline__ float sum8(const float* f) { return f[0] * f[0] + f[1] * f[1] + f[2] * f[2] + f[3] * f[3] + f[4] * f[4] + f[5] * f[5] + f[6] * f[6] + f[7] * f[7]; }
__device__ __forceinline__ float red8(float v) { v += __shfl_xor(v, 1); v += __shfl_xor(v, 2); v += __shfl_xor(v, 4); return v; }
__device__ __forceinline__ void tile_put(bf16_t* T, int tok, int j, u32x4 w) { unsigned* q = (unsigned*)(T + tok * 66 + 8 * j); q[0] = w.x; q[1] = w.y; q[2] = w.z; q[3] = w.w; }
__device__ __forceinline__ u32x4 tile_get_t(const bf16_t* T, int d, int tj) { unsigned short v[8];
#pragma unroll
    for (int e = 0; e < 8; ++e) v[e] = T[(8 * tj + e) * 66 + d];
    u32x4 w; w.x = v[0] | ((unsigned)v[1] << 16); w.y = v[2] | ((unsigned)v[3] << 16); w.z = v[4] | ((unsigned)v[5] << 16); w.w = v[6] | ((unsigned)v[7] << 16); return w; }

__device__ __forceinline__ void a2_transpose_store(const bf16_t* T, int lane, bf16_t* dstT) {
    const int tl = lane >> 3, j = lane & 7;
#pragma unroll
    for (int m = 0; m < 8; ++m) { const int d = 8 * m + tl; gst16(dstT + (size_t)d * LP + 8 * j, tile_get_t(T, d, j)); }
}
template <bool dry> __device__ __forceinline__ void phase_a2(const Params& p, int l, unsigned char* shm) {
    bf16_t* proj = (bf16_t*)(p.ws + OFF_PROJ);
    bf16_t* vst = (bf16_t*)(p.ws + OFF_VST); bf16_t* vrt = (bf16_t*)(p.ws + OFF_VRT); bf16_t* krt = (bf16_t*)(p.ws + OFF_KRT); bf16_t* ure = (bf16_t*)(p.ws + OFF_URE);
    const float* rot = (const float*)(p.ws + OFF_ROT);
    const int tid = tid_fresh(), wv = __builtin_amdgcn_readfirstlane(tid >> 6), lane = tid & 63, tl = lane >> 3, j = lane & 7;
    bf16_t* T = (bf16_t*)shm + wv * (64 * 66);
    constexpr int cm = dry ? 1023 : 0xffff;
    for (int e = blockIdx.x * 512 + tid; e < MROWS; e += gridDim.x * 512) { ((float*)(p.ws + OFF_SSQD))[e] = 0.f; ((float*)(p.ws + OFF_SSQ))[e] = 0.f; }
    if (!dry) for (int e = blockIdx.x * 512 + tid; e < MROWS * 12; e += gridDim.x * 512) { const int row = e / 12, sl = e - row * 12; float* hs = (float*)(p.ws + OFF_HSS) + e;
        ((float*)(p.ws + OFF_HINV))[(size_t)sl * MROWS + row] = rsqrtf(*hs * (1.0f / 64.0f) + RMS_EPS); *hs = 0.f; }
#pragma unroll 1
    for (int item = blockIdx.x * 8 + wv; item < (MROWS / 64) * 6; item += gridDim.x * 8) {
        const int tile = item / 6, slot = 6 + item - tile * 6, r0 = tile * 64; int b, i0; bi_of(r0, b, i0);
        if (slot < 6) { const int h = slot;
            float gq[8], gk[8];
#pragma unroll
            for (int e = 0; e < 8; ++e) { gq[e] = p.sb_q_g[l * 64 + 8 * j + e] * (0.125f * LOG2E); gk[e] = p.sb_k_g[l * 64 + 8 * j + e]; }
#pragma unroll 4
            for (int q = 0; q < 8; ++q) { const int tok = 8 * q + tl; bf16_t* prow = proj + (size_t)(r0 + tok) * DINP; bf16_t* orow = dry ? (bf16_t*)(p.ws + OFF_MIX) + (size_t)(r0 + tok) * 1024 : prow; float f[8];
                { unpack8(gld16(prow + 64 * h + 8 * j), f); const float inv = rsqrtf(red8(sum8(f)) * (1.0f / 64.0f) + RMS_EPS);
#pragma unroll
                  for (int e = 0; e < 8; ++e) f[e] *= inv * gq[e];
                  gst16(orow + ((64 * h) & cm) + 8 * j, pack8(f)); }
                { unpack8(gld16(prow + 384 + 64 * h + 8 * j), f); const float inv = rsqrtf(red8(sum8(f)) * (1.0f / 64.0f) + RMS_EPS);
#pragma unroll
                  for (int e = 0; e < 8; ++e) f[e] *= inv * gk[e];
                  gst16(orow + ((384 + 64 * h) & cm) + 8 * j, pack8(f)); }
                }
        } else { const int h = slot - 6; const float lg = log_gamma_h(h);
            float gq[8], gk[8];
#pragma unroll
            for (int e = 0; e < 8; ++e) { gq[e] = p.ret_q_g[l * 64 + 8 * j + e]; gk[e] = p.ret_k_g[l * 64 + 8 * j + e]; }
#pragma unroll 2
            for (int q = 0; q < 8; ++q) { const int tok = 8 * q + tl, i = i0 + tok; bf16_t* prow = proj + (size_t)(r0 + tok) * DINP; bf16_t* orow = dry ? (bf16_t*)(p.ws + OFF_MIX) + (size_t)(r0 + tok) * 1024 : prow;
                const float ex = lg * (float)((i & 127) + 1), qd = __expf(ex), kd = 0.125f * __expf(-ex);
                const float* cs = rot + ((size_t)i * 32 + 8 * (j & 3)) * 2; float c[8], sn[8], f[8], o[8];
#pragma unroll
                for (int e = 0; e < 4; ++e) { const f32x4 t = gld16f(cs + 4 * e); c[2 * e] = t.x; sn[2 * e] = t.y; c[2 * e + 1] = t.z; sn[2 * e + 1] = t.w; }
                { unpack8(gld16(prow + 1152 + 64 * h + 8 * j), f); const float inv = rsqrtf(red8(sum8(f)) * (1.0f / 64.0f) + RMS_EPS);
#pragma unroll
                  for (int e = 0; e < 8; ++e) f[e] *= inv * gq[e];
#pragma unroll
                  for (int e = 0; e < 8; ++e) { const float other = __shfl_xor(f[e], 4); o[e] = (j < 4 ? f[e] * c[e] - other * sn[e] : other * sn[e] + f[e] * c[e]) * qd; }
                  gst16(orow + ((1152 + 64 * h) & cm) + 8 * j, pack8(o)); }
                { unpack8(gld16(prow + 1536 + 64 * h + 8 * j), f); const float inv = rsqrtf(red8(sum8(f)) * (1.0f / 64.0f) + RMS_EPS);
#pragma unroll
                  for (int e = 0; e < 8; ++e) f[e] *= inv * gk[e];
#pragma unroll
                  for (int e = 0; e < 8; ++e) { const float other = __shfl_xor(f[e], 4); o[e] = (j < 4 ? f[e] * c[e] - other * sn[e] : other * sn[e] + f[e] * c[e]) * kd; }
                  const u32x4 w = pack8(o); gst16(orow + ((1536 + 64 * h) & cm) + 8 * j, w); tile_put(T, tok, j, w); } }
            __builtin_amdgcn_wave_barrier();
            a2_transpose_store(T, lane, krt + (size_t)(b * 6 + h) * 64 * LP + i0);
            __builtin_amdgcn_wave_barrier();
        }
    }
}

__device__ __forceinline__ bf16x8 ld16(const bf16_t* q) { return *(const bf16x8*)q; }
__device__ __forceinline__ bf16x8 gld16b(const bf16_t* q) { return *(const GAS bf16x8*)q; }
__device__ __forceinline__ bf16x8 gld8x2(const bf16_t* a, const bf16_t* b) { const bf16x4 x = *(const GAS bf16x4*)a, y = *(const GAS bf16x4*)b; bf16x8 r; r[0] = x[0]; r[1] = x[1]; r[2] = x[2]; r[3] = x[3]; r[4] = y[0]; r[5] = y[1]; r[6] = y[2]; r[7] = y[3]; return r; }
__device__ __forceinline__ bf16x8 ld8x2(const bf16_t* a, const bf16_t* b) { const bf16x4 x = *(const bf16x4*)a, y = *(const bf16x4*)b; bf16x8 r; r[0] = x[0]; r[1] = x[1]; r[2] = x[2]; r[3] = x[3]; r[4] = y[0]; r[5] = y[1]; r[6] = y[2]; r[7] = y[3]; return r; }
__device__ __forceinline__ bf16x8 pk8(const f32x16& v, int s) { u32x4 w; w.x = cvt_pk_bf16(v[8 * s + 0], v[8 * s + 1]); w.y = cvt_pk_bf16(v[8 * s + 2], v[8 * s + 3]); w.z = cvt_pk_bf16(v[8 * s + 4], v[8 * s + 5]); w.w = cvt_pk_bf16(v[8 * s + 6], v[8 * s + 7]);
    bf16x8 r; __builtin_memcpy(&r, &w, 16); return r; }

__device__ __forceinline__ void sb_wave(const Params& p, int widx) {
    const bf16_t* proj = (const bf16_t*)(p.ws + OFF_PROJ); const bf16_t* vst = (const bf16_t*)(p.ws + OFF_VST); bf16_t* mix = (bf16_t*)(p.ws + OFF_MIX);
    const int qt = widx % NCH32, bh = widx / NCH32, b = bh / 6, h = bh - b * 6, lane = tid_fresh() & 63, r = lane & 31, hh = lane >> 5;
    const size_t row0 = (size_t)row_of(b, qt * 32); bf16_t* orow = mix + (row0 + r) * 1024 + 64 * h;
    if (qt < 3) {
#pragma unroll
        for (int q = 0; q < 4; ++q) gst16(orow + 32 * hh + 8 * q, (u32x4){0u, 0u, 0u, 0u});
        return; }
    bf16x8 qf[4];
#pragma unroll
    for (int s = 0; s < 4; ++s) qf[s] = gld16b(proj + (row0 + r) * DINP + 64 * h + 16 * s + 8 * hh);
    f32x16 o0, o1;
#pragma unroll
    for (int e = 0; e < 16; ++e) { o0[e] = 0.f; o1[e] = 0.f; }
    float carry = 1.0f; const int qi = qt * 32 + r; const bf16_t* vb = vst + (size_t)bh * 64 * LP;
    const bf16_t* kbase = proj + (size_t)r * DINP + 384 + 64 * h + 8 * hh;
#define SB_KPTR(kt) (kbase + (size_t)row_of(b, (kt) * 32) * DINP)
    const float* hinv = (const float*)(p.ws + OFF_HINV); const float invq = gld4f(hinv + (size_t)h * MROWS + row0 + r);
    const float* ikbase = hinv + (size_t)(6 + h) * MROWS + 4 * hh;
#define SB_IKPTR(kt) (ikbase + (size_t)row_of(b, (kt) * 32))
    f32x4 ik[4], ikn[4];
#pragma unroll
    for (int jj = 0; jj < 4; ++jj) ik[jj] = gld16f(SB_IKPTR(qt) + 8 * jj);
    bf16x8 kf[4], kn[4];
#pragma unroll
    for (int s = 0; s < 4; ++s) kf[s] = gld16b(SB_KPTR(qt) + 16 * s);
    const bf16_t* vrow0 = vb + (size_t)r * LP + 4 * hh; const bf16_t* vrow1 = vrow0 + (size_t)32 * LP;
    bf16x8 va0 = gld8x2(vrow0 + qt * 32, vrow0 + qt * 32 + 8), va1 = gld8x2(vrow0 + qt * 32 + 16, vrow0 + qt * 32 + 24);
    bf16x8 vb0 = gld8x2(vrow1 + qt * 32, vrow1 + qt * 32 + 8), vb1 = gld8x2(vrow1 + qt * 32 + 16, vrow1 + qt * 32 + 24);
#pragma unroll 1
    for (int kt = qt; kt >= 3; --kt) {
        const int ktn = kt > 3 ? kt - 1 : kt;
#pragma unroll
        for (int s = 0; s < 4; ++s) kn[s] = gld16b(SB_KPTR(ktn) + 16 * s);
#pragma unroll
        for (int jj = 0; jj < 4; ++jj) ikn[jj] = gld16f(SB_IKPTR(ktn) + 8 * jj);
        const bf16x8 na0 = gld8x2(vrow0 + ktn * 32, vrow0 + ktn * 32 + 8), na1 = gld8x2(vrow0 + ktn * 32 + 16, vrow0 + ktn * 32 + 24);
        const bf16x8 nb0 = gld8x2(vrow1 + ktn * 32, vrow1 + ktn * 32 + 8), nb1 = gld8x2(vrow1 + ktn * 32 + 16, vrow1 + ktn * 32 + 24);
        f32x16 st;
#pragma unroll
        for (int e = 0; e < 16; ++e) st[e] = 0.f;
#pragma unroll
        for (int s = 0; s < 4; ++s) st = MFMA32(kf[s], qf[s], st);
        float T[4];
        if (kt == qt || kt == 3) {
#pragma unroll
            for (int jj = 0; jj < 4; ++jj) { float suf = 1.0f;
#pragma unroll
                for (int kk = 3; kk >= 0; --kk) { const int reg = 4 * jj + kk, key = kt * 32 + 8 * jj + 4 * hh + kk; const bool valid = key < qi && key >= 112;
                    const float ez = valid ? __builtin_amdgcn_exp2f(fminf(st[reg] * (invq * ik[jj][kk]), 100.0f)) : 0.0f; st[reg] = ez; suf *= 1.0f + ez; }
                T[jj] = suf; }
        } else {
#pragma unroll
            for (int jj = 0; jj < 4; ++jj) { float suf = 1.0f;
#pragma unroll
                for (int kk = 3; kk >= 0; --kk) { const int reg = 4 * jj + kk; const float ez = __builtin_amdgcn_exp2f(fminf(st[reg] * (invq * ik[jj][kk]), 100.0f)); st[reg] = ez; suf *= 1.0f + ez; }
                T[jj] = suf; }
        }
        float Tp[4], PP[4], tail[4];
#pragma unroll
        for (int jj = 0; jj < 4; ++jj) { Tp[jj] = __shfl_xor(T[jj], 32); PP[jj] = T[jj] * Tp[jj]; }
        tail[3] = 1.0f; tail[2] = PP[3]; tail[1] = PP[2] * tail[2]; tail[0] = PP[1] * tail[1];
        f32x16 w;
#pragma unroll
        for (int jj = 0; jj < 4; ++jj) { const float after = carry * tail[jj] * (hh == 0 ? Tp[jj] : 1.0f); float suf = 1.0f;
#pragma unroll
            for (int kk = 3; kk >= 0; --kk) { const int reg = 4 * jj + kk; const float e = st[reg]; suf *= 1.0f + e; w[reg] = e * __builtin_amdgcn_rcpf(after * suf); } }
        carry = carry * PP[0] * tail[0];
        const bf16x8 p0 = pk8(w, 0), p1 = pk8(w, 1);
        o0 = MFMA32(va0, p0, o0); o0 = MFMA32(va1, p1, o0);
        o1 = MFMA32(vb0, p0, o1); o1 = MFMA32(vb1, p1, o1);
#pragma unroll
        for (int s = 0; s < 4; ++s) kf[s] = kn[s];
        va0 = na0; va1 = na1; vb0 = nb0; vb1 = nb1;
#pragma unroll
        for (int jj = 0; jj < 4; ++jj) ik[jj] = ikn[jj];
        if (__all(carry > 4.2950e9f)) break;
    }
#pragma unroll
    for (int jj = 0; jj < 4; ++jj) { u32x2 a, c; a.x = cvt_pk_bf16(o0[4 * jj], o0[4 * jj + 1]); a.y = cvt_pk_bf16(o0[4 * jj + 2], o0[4 * jj + 3]); c.x = cvt_pk_bf16(o1[4 * jj], o1[4 * jj + 1]); c.y = cvt_pk_bf16(o1[4 * jj + 2], o1[4 * jj + 3]);
        gst8(orow + 8 * jj + 4 * hh, a); gst8(orow + 32 + 8 * jj + 4 * hh, c); }
}

__device__ __forceinline__ void ret_item(const Params& p, int l, int bh, unsigned char* shm) {
    const bf16_t* proj = (const bf16_t*)(p.ws + OFF_PROJ); const bf16_t* vrt = (const bf16_t*)(p.ws + OFF_VRT) + (size_t)bh * 64 * LP; const bf16_t* krt = (const bf16_t*)(p.ws + OFF_KRT) + (size_t)bh * 64 * LP;
    bf16_t* mix = (bf16_t*)(p.ws + OFF_MIX);
    const int b = bh / 6, h = bh - b * 6, tid = tid_fresh(), wv = __builtin_amdgcn_readfirstlane(tid >> 6), lane = tid & 63, r = lane & 31, hh = lane >> 5;
    bf16_t* LQ = (bf16_t*)shm; bf16_t* LK = LQ + 128 * 72; bf16_t* LVT = LK + 128 * 72; bf16_t* LKT = LVT + 64 * 136; bf16_t* ST = LKT + 64 * 136;
    for (int e = tid; e < 2 * 64 * 72 / 2; e += 512) ((unsigned*)ST)[e] = 0u;
    const int qrow = tid >> 3, qc = (tid & 7) * 8, trow = tid >> 4, tc = (tid & 15) * 8;
    const bf16_t* gq = proj + (size_t)qrow * DINP + 1152 + 64 * h + qc; const bf16_t* gk = gq + 384;
    const bf16_t* gvt = vrt + (size_t)trow * LP + tc; const bf16_t* gkt = krt + (size_t)trow * LP + tc;
    u32x4 pre[8];
#define RET_ISSUE(n) do { const size_t ro = (size_t)row_of(b, (n) * 128) * DINP; \
        pre[0] = gld16(gq + ro); pre[1] = gld16(gq + ro + (size_t)64 * DINP); pre[2] = gld16(gk + ro); pre[3] = gld16(gk + ro + (size_t)64 * DINP); \
        pre[4] = gld16(gvt + (n) * 128); pre[5] = gld16(gvt + (size_t)32 * LP + (n) * 128); pre[6] = gld16(gkt + (n) * 128); pre[7] = gld16(gkt + (size_t)32 * LP + (n) * 128); } while (0)
#define RET_COMMIT() do { *(u32x4*)(LQ + qrow * 72 + qc) = pre[0]; *(u32x4*)(LQ + (qrow + 64) * 72 + qc) = pre[1]; *(u32x4*)(LK + qrow * 72 + qc) = pre[2]; *(u32x4*)(LK + (qrow + 64) * 72 + qc) = pre[3]; \
        *(u32x4*)(LVT + trow * 136 + tc) = pre[4]; *(u32x4*)(LVT + (trow + 32) * 136 + tc) = pre[5]; *(u32x4*)(LKT + trow * 136 + tc) = pre[6]; *(u32x4*)(LKT + (trow + 32) * 136 + tc) = pre[7]; } while (0)
    RET_ISSUE(0); RET_COMMIT(); RET_ISSUE(1);
    __syncthreads();
    const float lg = log_gamma_h(h), cdec = __expf(lg * 128.0f);
    f32x16 sacc;
#pragma unroll
    for (int e = 0; e < 16; ++e) sacc[e] = 0.f;
    f32x4 ogv[8];
#pragma unroll
    for (int q = 0; q < 8; ++q) ogv[q] = *(const f32x4*)(p.ret_out_g + l * 384 + 64 * h + 32 * (q >> 2) + 8 * (q & 3) + 4 * hh);
#pragma unroll 1
    for (int n = 0; n < LP / 128; ++n) {
        const bf16_t* Sc = ST + (n & 1) * 64 * 72; bf16_t* Sn = ST + ((n & 1) ^ 1) * 64 * 72;
        const size_t row0 = (size_t)row_of(b, n * 128) + 32 * (wv & 3);
        u32x2 gw[8]; f32x16 o0, o1;
        if (wv < 4) {
            const bf16_t* grow = proj + (row0 + r) * DINP + 2304 + 64 * h;
#pragma unroll
            for (int q = 0; q < 8; ++q) gw[q] = gld8(grow + 32 * (q >> 2) + 8 * (q & 3) + 4 * hh);
            bf16x8 qf[4];
#pragma unroll
            for (int s = 0; s < 4; ++s) qf[s] = *(const bf16x8*)(LQ + (32 * wv + r) * 72 + 16 * s + 8 * hh);
#pragma unroll
            for (int e = 0; e < 16; ++e) { o0[e] = 0.f; o1[e] = 0.f; }
            { bf16x8 sa[4], sb[4];
#pragma unroll
              for (int s = 0; s < 4; ++s) { sa[s] = *(const bf16x8*)(Sc + r * 72 + 16 * s + 8 * hh); sb[s] = *(const bf16x8*)(Sc + (32 + r) * 72 + 16 * s + 8 * hh); }
              __builtin_amdgcn_sched_barrier(0);
#pragma unroll
              for (int s = 0; s < 4; ++s) { o0 = MFMA32(sa[s], qf[s], o0); o1 = MFMA32(sb[s], qf[s], o1); } }
#pragma unroll
            for (int kt = 0; kt < 4; ++kt) { if (kt > wv) break;
                bf16x8 kf[4];
#pragma unroll
                for (int s = 0; s < 4; ++s) kf[s] = *(const bf16x8*)(LK + (32 * kt + r) * 72 + 16 * s + 8 * hh);
                const bf16_t* v0 = LVT + r * 136 + kt * 32 + 4 * hh; const bf16_t* v1 = v0 + 32 * 136;
                const bf16x8 va0 = ld8x2(v0, v0 + 8), va1 = ld8x2(v0 + 16, v0 + 24), vb0 = ld8x2(v1, v1 + 8), vb1 = ld8x2(v1 + 16, v1 + 24);
                __builtin_amdgcn_sched_barrier(0);
                f32x16 st;
#pragma unroll
                for (int e = 0; e < 16; ++e) st[e] = 0.f;
#pragma unroll
                for (int s = 0; s < 4; ++s) st = MFMA32(kf[s], qf[s], st);
                if (kt == wv) {
#pragma unroll
                    for (int reg = 0; reg < 16; ++reg) { const int key = 8 * (reg >> 2) + 4 * hh + (reg & 3); st[reg] = key <= r ? st[reg] : 0.f; } }
                const bf16x8 p0 = pk8(st, 0), p1 = pk8(st, 1);
                o0 = MFMA32(va0, p0, o0); o1 = MFMA32(vb0, p0, o1); o0 = MFMA32(va1, p1, o0); o1 = MFMA32(vb1, p1, o1);
            }
        } else {
            const int di = (wv - 4) >> 1, ei = (wv - 4) & 1;
            const bf16_t* kp = LKT + (32 * di + r) * 136 + 8 * hh; const bf16_t* vp = LVT + (32 * ei + r) * 136 + 8 * hh;
#pragma unroll
            for (int s = 0; s < 8; ++s) sacc = MFMA32(*(const bf16x8*)(kp + 16 * s), *(const bf16x8*)(vp + 16 * s), sacc);
#pragma unroll
            for (int e = 0; e < 16; ++e) sacc[e] *= cdec;
#pragma unroll
            for (int jj = 0; jj < 4; ++jj) { u32x2 w; w.x = cvt_pk_bf16(sacc[4 * jj], sacc[4 * jj + 1]); w.y = cvt_pk_bf16(sacc[4 * jj + 2], sacc[4 * jj + 3]);
                *(u32x2*)(Sn + (32 * ei + r) * 72 + 32 * di + 8 * jj + 4 * hh) = w; }
        }
        __syncthreads();
        if (n + 1 < LP / 128) RET_COMMIT();
        if (n + 2 < LP / 128) RET_ISSUE(n + 2);
        if (wv < 4) {
            float ss = 0.f;
#pragma unroll
            for (int e = 0; e < 16; ++e) ss += o0[e] * o0[e] + o1[e] * o1[e];
            ss += __shfl_xor(ss, 32);
            const float inv = rsqrtf(ss * (1.0f / 64.0f) + RMS_EPS);
            bf16_t* orow = mix + (row0 + r) * 1024 + 384 + 64 * h;
#pragma unroll
            for (int t2 = 0; t2 < 2; ++t2)
#pragma unroll
                for (int jj = 0; jj < 4; ++jj) { const int e0 = 32 * t2 + 8 * jj + 4 * hh; const u32x2 gwv = gw[4 * t2 + jj]; const f32x4 gg = ogv[4 * t2 + jj];
                    const float g0 = lo_bf(gwv.x), g1 = hi_bf(gwv.x), g2 = lo_bf(gwv.y), g3 = hi_bf(gwv.y);
                    const float a0 = (t2 ? o1[4 * jj] : o0[4 * jj]) * inv * gg[0] * g0 * sigmoidf_(g0), a1 = (t2 ? o1[4 * jj + 1] : o0[4 * jj + 1]) * inv * gg[1] * g1 * sigmoidf_(g1);
                    const float a2 = (t2 ? o1[4 * jj + 2] : o0[4 * jj + 2]) * inv * gg[2] * g2 * sigmoidf_(g2), a3 = (t2 ? o1[4 * jj + 3] : o0[4 * jj + 3]) * inv * gg[3] * g3 * sigmoidf_(g3);
                    u32x2 w; w.x = cvt_pk_bf16(a0, a1); w.y = cvt_pk_bf16(a2, a3); gst8(orow + e0, w); }
        }
        __syncthreads();
    }
#undef RET_ISSUE
#undef RET_COMMIT
}

__device__ __forceinline__ void phase_b_items(const Params& p, int l, int ci, unsigned char* shm, volatile int* s_itemp, int only = 0) {
    unsigned* ctr = (unsigned*)(p.ws + OFF_CTR) + ci;
    constexpr int N_RET = NBATCH * 6, N_SB = NBATCH * 6 * NCH32 / 16;
#pragma unroll 1
    for (;;) {
        __syncthreads();
        if (threadIdx.x == 0) *s_itemp = (int)atomicAdd(ctr, 1u);
        __syncthreads();
        const int item = __builtin_amdgcn_readfirstlane(*s_itemp);
        if (item >= N_RET + N_SB) break;
        if (item < N_RET) { if (only != 2) ret_item(p, l, item, shm); }
        else if (only != 1) { const int w0 = (item - N_RET) * 16 + __builtin_amdgcn_readfirstlane(tid_fresh() >> 6); sb_wave(p, w0); sb_wave(p, w0 + 8); }
    }
}

__device__ __forceinline__ void phase_s5_scan(const Params& p, int l) {
    const int gt = ((int)gridDim.x - 1 - (int)blockIdx.x) * 512 + tid_fresh(); if (gt < 16 * 16 * 64) {
    const int pp = gt & 63, b = (gt >> 6) & 15, g = gt >> 10;
    const float* pw = (const float*)(p.ws + OFF_S5P + (size_t)l * SZ_S5P + S5P_PW) + (size_t)(g * 64 + pp) * 66; const float ar = pw[64], ai = pw[65];
    const float* xe = (const float*)(p.ws + OFF_XEND) + ((size_t)g * S5ROWS + b * NCH32) * 128; bf16_t* xs = (bf16_t*)(p.ws + OFF_XST) + ((size_t)g * S5ROWS + b * NCH32) * 256;
    float xr = 0.f, xi = 0.f;
#pragma unroll 1
    for (int n0 = 0; n0 < NCH32; n0 += 12) { float er[12], ei[12];
#pragma unroll
        for (int q = 0; q < 12; ++q) { er[q] = xe[(n0 + q) * 128 + pp]; ei[q] = xe[(n0 + q) * 128 + 64 + pp]; }
#pragma unroll
        for (int q = 0; q < 12; ++q) { const int n = n0 + q; xs[n * 256 + pp] = f2bf(xr); xs[n * 256 + 64 + pp] = f2bf(xi); xs[n * 256 + 128 + pp] = 0; xs[n * 256 + 192 + pp] = 0;
            const float nr = ar * xr - ai * xi + er[q], ni = ar * xi + ai * xr + ei[q]; xr = nr; xi = ni; } }
    }
}

__device__ __forceinline__ Params fresh(Params p) { asm volatile("" : "+s"(p.ws), "+s"(p.out), "+s"(p.x)); return p; }
__global__ void __launch_bounds__(512, 2) hymba_fwd(Params p0) {
    extern __shared__ __attribute__((aligned(16))) unsigned char shm[];
    cg::grid_group grid = cg::this_grid();
    PG8_LAS unsigned char* lds = (PG8_LAS unsigned char*)shm;
    __shared__ uint4 s_misc;
    if (threadIdx.x == 0) s_misc = make_uint4(0u, 0u, 0u, 0u);
    __syncthreads();
    const XcdBarrier xb = xcd_barrier_post((unsigned*)(p0.ws + OFF_BAR), (volatile LAS unsigned*)&s_misc);
    for (int rep = 0; rep < ((DUP_MASK >> 3) & 1) + 1; ++rep) {
    phase_prep1(fresh(p0), shm);
    if (__builtin_expect(p0.ws == nullptr, 0)) grid.sync();
    xcd_barrier(xb);
    phase_prep2(fresh(p0));
    xcd_barrier(xb); }
    for (int rep = 0; rep < EXTRA_SYNCS; ++rep) xcd_barrier(xb);
#pragma unroll 1
    for (int l0 = 0; l0 < 2; ++l0) {
        for (int rep = 0; rep < ((DUP_MASK >> 0) & 1) + 1; ++rep) {
        { const Params p = fresh(p0); const int l = sgpr_fresh(l0), G = sgpr_fresh((int)gridDim.x), c = sgpr_fresh((int)blockIdx.x); const unsigned char* wl = p.ws + OFF_W + (size_t)l * SZ_WL;
          StaticOrder S; S.init(MROWS, DINP, G, c); EpiProj E{(bf16_t*)(p.ws + OFF_PROJ), (const float*)(p.ws + OFF_SSQ), (bf16_t*)(p.ws + OFF_URE), (bf16_t*)(p.ws + OFF_VST), (bf16_t*)(p.ws + OFF_VRT), (float*)(p.ws + OFF_HSS), p.sb_q_g + l * 64, p.sb_k_g + l * 64};
          gemm_phase<EpiProj, StaticOrder>(lds, Gemm{(const bf16_t*)(p.ws + OFF_HB), (const bf16_t*)(wl + WL_IN), MROWS, DINP, 1024}, S, E, nullptr); }
        if (rep + 1 < ((DUP_MASK >> 0) & 1) + 1) xcd_barrier(xb); }
        xcd_barrier(xb);
#if (DUP_MASK >> 5) & 1
        phase_a2<true>(fresh(p0), sgpr_fresh(l0), shm); xcd_barrier(xb);
#endif
        phase_a2<false>(fresh(p0), sgpr_fresh(l0), shm);
        xcd_barrier(xb);
        for (int rep = 0; rep < ((DUP_MASK >> 2) & 1) + 1; ++rep) {
        if (!(B_ONLY && rep == 0 && ((DUP_MASK >> 2) & 1))) { const Params p = fresh(p0); const int l = sgpr_fresh(l0), G = sgpr_fresh((int)gridDim.x), c = sgpr_fresh((int)blockIdx.x); const unsigned char* sm = p.ws + OFF_S5M + (size_t)l * SZ_S5M;
          BatchedOrder S; S.init(16, 9, 3, G, c); EpiS5a E{(bf16_t*)(p.ws + OFF_YLOC), (float*)(p.ws + OFF_XEND)};
          gemm_phase<EpiS5a, BatchedOrder>(lds, Gemm{(const bf16_t*)(p.ws + OFF_URE), (const bf16_t*)(sm + S5M_BT1), 16 * S5ROWS, 16 * 768, 512}, S, E, nullptr); }
        xcd_barrier(xb);
        phase_s5_scan(fresh(p0), sgpr_fresh(l0));
        phase_b_items(fresh(p0), sgpr_fresh(l0), sgpr_fresh(l0 + 2 * rep), shm, (volatile int*)&s_misc.z, (rep == 0 && ((DUP_MASK >> 2) & 1)) ? B_ONLY : 0);
        if (rep + 1 < ((DUP_MASK >> 2) & 1) + 1) xcd_barrier(xb); }
        xcd_barrier(xb);
        for (int rep = 0; rep < ((DUP_MASK >> 4) & 1) + 1; ++rep) {
        { const Params p = fresh(p0); const int l = sgpr_fresh(l0), G = sgpr_fresh((int)gridDim.x), c = sgpr_fresh((int)blockIdx.x); const unsigned char* sm = p.ws + OFF_S5M + (size_t)l * SZ_S5M;
          BatchedOrder S; S.init(16, 9, 2, G, c); EpiS5b E{(const bf16_t*)(p.ws + OFF_YLOC), (const bf16_t*)(p.ws + OFF_URE), p.s5_d + l * 256, (bf16_t*)(p.ws + OFF_YBUF)};
          gemm_phase<EpiS5b, BatchedOrder>(lds, Gemm{(const bf16_t*)(p.ws + OFF_XST), (const bf16_t*)(sm + S5M_E), 16 * S5ROWS, 16 * 512, 256}, S, E, nullptr); }
        xcd_barrier(xb);
        { const Params p = fresh(p0); const int l = sgpr_fresh(l0), G = sgpr_fresh((int)gridDim.x), c = sgpr_fresh((int)blockIdx.x); const unsigned char* wl = p.ws + OFF_W + (size_t)l * SZ_WL;
          StaticOrder S; S.init(l == 1 ? NREAL : MROWS, 256, G, c); EpiGlu E{(const bf16_t*)(p.ws + OFF_YBUF), (bf16_t*)(p.ws + OFF_MIX)};
          gemm_phase<EpiGlu, StaticOrder>(lds, Gemm{(const bf16_t*)(p.ws + OFF_YBUF), (const bf16_t*)(wl + WL_GLU), MROWS, 256, 256}, S, E, nullptr); }
        if (rep + 1 < ((DUP_MASK >> 4) & 1) + 1) xcd_barrier(xb); }
        xcd_barrier(xb);
        { const Params p = fresh(p0); const int l = sgpr_fresh(l0), G = sgpr_fresh((int)gridDim.x), c = sgpr_fresh((int)blockIdx.x); const unsigned char* wl = p.ws + OFF_W + (size_t)l * SZ_WL;
          StaticOrder S; S.init(l == 1 ? NREAL : MROWS, 1024, G, c); EpiRes E{(bf16_t*)(p.ws + OFF_HB), (float*)(p.ws + OFF_SSQD), p.out, 0};
          gemm_phase<EpiRes, StaticOrder>(lds, Gemm{(const bf16_t*)(p.ws + OFF_MIX), (const bf16_t*)(wl + WL_OUT), MROWS, 1024, 1024}, S, E, nullptr); }
        xcd_barrier(xb);
        for (int rep = 0; rep < ((DUP_MASK >> 1) & 1) + 1; ++rep) {
        { const Params p = fresh(p0); const int l = sgpr_fresh(l0), G = sgpr_fresh((int)gridDim.x), c = sgpr_fresh((int)blockIdx.x); const unsigned char* wl = p.ws + OFF_W + (size_t)l * SZ_WL;
          StaticOrder S; S.init(l == 1 ? NREAL : MROWS, 5632, G, c); EpiAct E{(bf16_t*)(p.ws + OFF_ACT), (const float*)(p.ws + OFF_SSQD)};
          if (DUP_NOP && rep == 0) { EpiNop E0{(float*)(p.ws + OFF_CTR + 128)}; gemm_phase<EpiNop, StaticOrder>(lds, Gemm{(const bf16_t*)(p.ws + OFF_HB), (const bf16_t*)(wl + WL_GU), MROWS, 5632, 1024}, S, E0, nullptr); }
          else gemm_phase<EpiAct, StaticOrder>(lds, Gemm{(const bf16_t*)(p.ws + OFF_HB), (const bf16_t*)(wl + WL_GU), MROWS, 5632, 1024}, S, E, nullptr); }
        if (rep + 1 < ((DUP_MASK >> 1) & 1) + 1) xcd_barrier(xb); }
        xcd_barrier(xb);
        { const Params p = fresh(p0); const int l = sgpr_fresh(l0), G = sgpr_fresh((int)gridDim.x), c = sgpr_fresh((int)blockIdx.x); const unsigned char* wl = p.ws + OFF_W + (size_t)l * SZ_WL;
          StaticOrder S; S.init(l == 1 ? NREAL : MROWS, 1024, G, c); EpiRes E{(bf16_t*)(p.ws + OFF_HB), (float*)(p.ws + OFF_SSQ), p.out, l == 1 ? 1 : 0};
          gemm_phase<EpiRes, StaticOrder>(lds, Gemm{(const bf16_t*)(p.ws + OFF_ACT), (const bf16_t*)(wl + WL_DN), MROWS, 1024, DFF}, S, E, nullptr); }
        xcd_barrier(xb);
    }
}

extern "C" void kernel_launch(void* const* d_in, const int* in_sizes, int n_in, void* d_out, int out_size, void* d_ws, size_t ws_size, hipStream_t stream) {
    constexpr size_t kDynLds = STAGE_BYTES;
    static int grid_blocks = 0;
    if (!grid_blocks) {
        hipFuncSetAttribute((const void*)hymba_fwd, hipFuncAttributeMaxDynamicSharedMemorySize, (int)kDynLds);
        int dev = 0, cus = 0, per_cu = 0;
        hipGetDevice(&dev);
        hipDeviceGetAttribute(&cus, hipDeviceAttributeMultiprocessorCount, dev);
        hipOccupancyMaxActiveBlocksPerMultiprocessor(&per_cu, hymba_fwd, 512, kDynLds);
        if (per_cu > 1) per_cu = 1;
        grid_blocks = cus * per_cu;
    }
    Params p{};
    const float** f = (const float**)&p;
    for (int i = 0; i < 23; ++i) f[i] = (const float*)d_in[i];
    p.out = (float*)d_out; p.ws = (unsigned char*)d_ws;
    hipMemsetAsync((unsigned char*)d_ws + OFF_BAR, 0, (size_t)XCD_BAR_WORDS_C * 4, stream);
    void* args[] = {&p};
    hipError_t e = hipLaunchCooperativeKernel((void*)hymba_fwd, dim3(grid_blocks), dim3(512), args, kDynLds, stream);
    if (e != hipSuccess) fprintf(stderr, "cooperative launch failed: %s (grid %d)\n", hipGetErrorString(e), grid_blocks);
}
```
